# Optimizing an MI355X kernel written in HIP

```python
import math
import jax, jax.numpy as jnp
from jax import lax
import numpy as np

D_MODEL = 1024
BATCH = 8
SEQ = 4096
DEPTH = 1

GRID_W = 64
CTX_LEN = 256
MIX_WIDTH = D_MODEL
ATT_WIDTH = MIX_WIDTH // 2
POOL_WIDTH = MIX_WIDTH - ATT_WIDTH
ATT_HEADS = 4
ATT_HEAD_DIM = ATT_WIDTH // ATT_HEADS
QK_DIM = ATT_HEAD_DIM // 2
POOL_WINDOWS = (2, 4, 8, 16)
POOL_GROUPS = len(POOL_WINDOWS)
POOL_GROUP_DIM = POOL_WIDTH // POOL_GROUPS
IN_WIDTH = 3 * ATT_WIDTH + POOL_WIDTH
D_FF = ((8 * D_MODEL // 3 + 255) // 256) * 256
N_MOD = 9
ROPE_BASE = 10000.0
Q_BLOCK = 128
EPS = 1e-6

kernel_name = "hybrid_diffattn_pool_macaron_dit_layer"


def _lambda_init(layer):
    return 0.8 - 0.6 * math.exp(-0.3 * layer)


def rms_norm(x, g):
    xf = x.astype(jnp.float32)
    y = xf * lax.rsqrt(jnp.mean(xf * xf, axis=-1, keepdims=True) + EPS)
    return (y * g.astype(jnp.float32)).astype(x.dtype)


def adaln_params(cond, w, b):
    m = (jax.nn.silu(cond) @ w + b).reshape(-1, 1, N_MOD, D_MODEL)
    return [m[:, :, i] for i in range(N_MOD)]


def modulate(h, shift, scale):
    return h * (1 + scale) + shift


def swiglu(h, w_in, w_out):
    gate, up = jnp.split(h @ w_in, 2, axis=-1)
    return (jax.nn.silu(gate) * up) @ w_out


def axial_rope_tables(n):
    rows = n // GRID_W
    row = jnp.repeat(jnp.arange(rows, dtype=jnp.float32), GRID_W)
    col = jnp.tile(jnp.arange(GRID_W, dtype=jnp.float32), rows)
    nf = QK_DIM // 4
    freqs = ROPE_BASE ** (-jnp.arange(nf, dtype=jnp.float32) / nf)
    ar = row[:, None] * freqs
    ac = col[:, None] * freqs
    ang = jnp.concatenate([ar, ar, ac, ac], axis=-1)
    return jnp.cos(ang), jnp.sin(ang)


def apply_axial_rope(t, cos, sin):
    tf = t.astype(jnp.float32)
    tr = tf.reshape(tf.shape[:-1] + (2, 2, QK_DIM // 4))
    rot = jnp.stack([-tr[..., 1, :], tr[..., 0, :]], axis=-2).reshape(tf.shape)
    c = cos[None, :, None, None, :]
    s = sin[None, :, None, None, :]
    return (tf * c + rot * s).astype(t.dtype)


def split_qk(t):
    b, n, _ = t.shape
    return t.reshape(b, n, ATT_HEADS, 2, QK_DIM)


def split_v(t):
    b, n, _ = t.shape
    return t.reshape(b, n, ATT_HEADS, ATT_HEAD_DIM).transpose(0, 2, 1, 3)


def diff_attention(q, k, v, lam, g_sub, lam_init):
    s = jnp.einsum('bhmqd,bhmkd->bhmqk', q, k).astype(jnp.float32) * (QK_DIM ** -0.5)
    p = jax.nn.softmax(s, axis=-1)
    a = p[:, :, 0] - lam * p[:, :, 1]
    o = jnp.einsum('bhqk,bhkv->bhqv', a.astype(v.dtype), v)
    return rms_norm(o, g_sub) * (1.0 - lam_init)


def multiscale_pool(u, w_pool, pool_scale):
    b, n, _ = u.shape
    uf = u.astype(jnp.float32)
    csum = jnp.concatenate([jnp.zeros((b, 1, POOL_WIDTH), jnp.float32), jnp.cumsum(uf, axis=1)], axis=1)
    t = jnp.arange(n)
    outs = []
    for gi, w in enumerate(POOL_WINDOWS):
        lo = w // 2
        hi = w - w // 2 - 1
        start = jnp.maximum(t - lo, 0)
        end = jnp.minimum(t + hi, n - 1)
        sl = slice(gi * POOL_GROUP_DIM, (gi + 1) * POOL_GROUP_DIM)
        seg = csum[..., sl]
        total = jnp.take(seg, end + 1, axis=1) - jnp.take(seg, start, axis=1)
        cnt = (end - start + 1).astype(jnp.float32)
        diff = (total / cnt[None, :, None] - uf[..., sl]).astype(u.dtype)
        outs.append(diff @ w_pool[gi])
    return jnp.concatenate(outs, axis=-1) * pool_scale


def setup_inputs(seed: int = 0) -> dict:
    key = jax.random.key(seed)
    ks = jax.random.split(key, 24)
    f32 = jnp.float32
    nrm = lambda k, shape, s: jax.random.normal(k, shape, f32) * s
    gain = lambda k, shape: 1.0 + 0.05 * jax.random.normal(k, shape, f32)
    L, D = DEPTH, D_MODEL
    return {
        "x": nrm(ks[0], (BATCH, SEQ, D), 1.0),
        "c": nrm(ks[1], (BATCH, D), 1.0),
        "ctx": nrm(ks[2], (BATCH, CTX_LEN, D), 1.0),
        "c_ctx": nrm(ks[3], (D,), 1.0),
        "w_mod": nrm(ks[4], (L, D, N_MOD * D), 0.5 * D ** -0.5),
        "b_mod": nrm(ks[5], (L, N_MOD * D), 0.01),
        "g_ffn1": gain(ks[6], (L, D)),
        "ffn1_w_in": nrm(ks[7], (L, D, 2 * D_FF), D ** -0.5),
        "ffn1_w_out": nrm(ks[8], (L, D_FF, D), D_FF ** -0.5),
        "g_mix": gain(ks[9], (L, D)),
        "w_in": nrm(ks[10], (L, D, IN_WIDTH), D ** -0.5),
        "lambda_q1": nrm(ks[11], (L, QK_DIM), 0.1),
        "lambda_k1": nrm(ks[12], (L, QK_DIM), 0.1),
        "lambda_q2": nrm(ks[13], (L, QK_DIM), 0.1),
        "lambda_k2": nrm(ks[14], (L, QK_DIM), 0.1),
        "g_sub": gain(ks[15], (L, ATT_HEAD_DIM)),
        "w_pool": nrm(ks[16], (L, POOL_GROUPS, POOL_GROUP_DIM, POOL_GROUP_DIM), POOL_GROUP_DIM ** -0.5),
        "pool_scale": gain(ks[17], (L, POOL_WIDTH)),
        "w_out": nrm(ks[18], (L, MIX_WIDTH, D), MIX_WIDTH ** -0.5),
        "g_ffn2": gain(ks[19], (L, D)),
        "ffn2_w_in": nrm(ks[20], (L, D, 2 * D_FF), D ** -0.5),
        "ffn2_w_out": nrm(ks[21], (L, D_FF, D), D_FF ** -0.5),
        "g_final": gain(ks[22], (D,)),
    }


def reference(x, c, ctx, c_ctx, w_mod, b_mod, g_ffn1, ffn1_w_in, ffn1_w_out, g_mix, w_in,
              lambda_q1, lambda_k1, lambda_q2, lambda_k2, g_sub, w_pool, pool_scale, w_out,
              g_ffn2, ffn2_w_in, ffn2_w_out, g_final):
    b, n, _ = x.shape
    nblk = n // Q_BLOCK
    cos, sin = axial_rope_tables(n)
    cx = ctx
    for l in range(DEPTH):
        last = l == DEPTH - 1
        sh1, sc1, gt1, sh2, sc2, gt2, sh3, sc3, gt3 = adaln_params(c, w_mod[l], b_mod[l])
        ch1, cc1, cg1, ch2, cc2, cg2, ch3, cc3, cg3 = adaln_params(c_ctx, w_mod[l], b_mod[l])

        x = x + 0.5 * gt1 * swiglu(modulate(rms_norm(x, g_ffn1[l]), sh1, sc1), ffn1_w_in[l], ffn1_w_out[l])
        cx = cx + 0.5 * cg1 * swiglu(modulate(rms_norm(cx, g_ffn1[l]), ch1, cc1), ffn1_w_in[l], ffn1_w_out[l])

        hx = modulate(rms_norm(x, g_mix[l]), sh2, sc2) @ w_in[l]
        hc = modulate(rms_norm(cx, g_mix[l]), ch2, cc2) @ w_in[l]
        qx, kx, vx, ux = jnp.split(hx, [ATT_WIDTH, 2 * ATT_WIDTH, 3 * ATT_WIDTH], axis=-1)
        qc, kc, vc, uc = jnp.split(hc, [ATT_WIDTH, 2 * ATT_WIDTH, 3 * ATT_WIDTH], axis=-1)

        lam_init = _lambda_init(l)
        lam = (jnp.exp(jnp.sum(lambda_q1[l].astype(jnp.float32) * lambda_k1[l].astype(jnp.float32)))
               - jnp.exp(jnp.sum(lambda_q2[l].astype(jnp.float32) * lambda_k2[l].astype(jnp.float32)))
               + lam_init)

        q_lat = apply_axial_rope(split_qk(qx), cos, sin).transpose(0, 2, 3, 1, 4)
        k_lat = apply_axial_rope(split_qk(kx), cos, sin).transpose(0, 2, 3, 1, 4)
        q_ctx = split_qk(qc).transpose(0, 2, 3, 1, 4)
        k_ctx = split_qk(kc).transpose(0, 2, 3, 1, 4)
        v_lat, v_ctx = split_v(vx), split_v(vc)
        k_all = jnp.concatenate([k_lat, k_ctx], axis=3)
        v_all = jnp.concatenate([v_lat, v_ctx], axis=2)

        qb = q_lat.reshape(b, ATT_HEADS, 2, nblk, Q_BLOCK, QK_DIM).transpose(3, 0, 1, 2, 4, 5)
        att = lax.map(lambda qq: diff_attention(qq, k_all, v_all, lam, g_sub[l], lam_init), qb)
        att_lat = att.transpose(1, 0, 3, 2, 4).reshape(b, n, ATT_WIDTH)
        pool_lat = multiscale_pool(ux, w_pool[l], pool_scale[l])
        x = x + gt2 * (jnp.concatenate([att_lat, pool_lat], axis=-1) @ w_out[l])

        if not last:
            att_c = diff_attention(q_ctx, k_ctx, v_ctx, lam, g_sub[l], lam_init)
            att_c = att_c.transpose(0, 2, 1, 3).reshape(cx.shape[0], cx.shape[1], ATT_WIDTH)
            pool_c = multiscale_pool(uc, w_pool[l], pool_scale[l])
            cx = cx + cg2 * (jnp.concatenate([att_c, pool_c], axis=-1) @ w_out[l])
            cx = cx + 0.5 * cg3 * swiglu(modulate(rms_norm(cx, g_ffn2[l]), ch3, cc3), ffn2_w_in[l], ffn2_w_out[l])

        x = x + 0.5 * gt3 * swiglu(modulate(rms_norm(x, g_ffn2[l]), sh3, sc3), ffn2_w_in[l], ffn2_w_out[l])

    return rms_norm(x, g_final)
```

```cpp
#include <hip/hip_runtime.h>
#include <cstdio>
#include <cstdint>
#include <cmath>
namespace pg8 {
#define PG8_LAS __attribute__((address_space(3)))
typedef unsigned short bf16_t;
typedef short bf16x8 __attribute__((ext_vector_type(8)));
typedef float f32x4 __attribute__((ext_vector_type(4)));
typedef unsigned u32x4 __attribute__((ext_vector_type(4)));
constexpr int BM = 256, BK = 64, HALF = 128, HTB = HALF * BK * 2  , STAGE_BYTES = 8 * HTB, NXCD = 8, WGM = 8;

__host__ __device__ __forceinline__ int lds_byte(int r, int c) { const int st = (r >> 4) * 2 + (c >> 5), rr = r & 15, cc = c & 31, ob = rr * 64 + cc * 2; return st * 1024 + (ob ^ (((ob >> 9) & 1) << 5)); }
__host__ __device__ __forceinline__ void stage_rc(int b, int& R, int& C) { const int st = b / 1024, sb = b % 1024, swz = sb ^ (((sb >> 9) & 1) << 5); R = (st >> 1) * 16 + swz / 64; C = (st & 1) * 32 + (swz % 64) / 2; }
__host__ __device__ __forceinline__ int perm32(int rho) { const int n = rho >> 4, i = rho & 15; return 8 * (i >> 2) + 4 * n + (i & 3); }

struct Unit { int pm, pn, kt0, nk; };
struct Gemm { const bf16_t* A; const bf16_t* Bt; int M, N, K; };

struct StaticOrder {
    int nM, nN, nwg, G, c, nkt;
    __host__ __device__ void init(int M, int N, int G_, int c_, int K_) { nM = M / BM; nN = N / BM; nwg = nM * nN; G = G_; c = c_; nkt = K_ / BK; }
    __host__ __device__ bool next(int i, Unit& u) const {
        const long L = (long)i * G + c; if (L >= nwg) return false;
        int wgid = (int)L; { const int q = nwg / NXCD, r = nwg % NXCD, xcd = wgid % NXCD, off = wgid / NXCD; wgid = (xcd < r ? xcd * (q + 1) : r * (q + 1) + (xcd - r) * q) + off; }
        const int nig = WGM * nN, gid = wgid / nig, fm = gid * WGM, gsz = (nM - fm) < WGM ? (nM - fm) : WGM;
        u.pm = fm + ((wgid % nig) % gsz); u.pn = (wgid % nig) / gsz; u.kt0 = 0; u.nk = nkt; return true;
    }
    __device__ __forceinline__ void a_ready(const Unit&) const {}
    __device__ __forceinline__ void done(const Unit&) const {}
};

struct SplitOrder {
    StaticOrder S; int nfull, G, c;
    __host__ __device__ void init(int Mlat, int N, int G_, int c_, int K_) { S.init(Mlat, N, G_, c_, K_); nfull = S.nwg; G = G_; c = c_; }
    __host__ __device__ bool next(int i, Unit& u) const {
        const long L = (long)i * G + c;
        if (L < nfull) return S.next(i, u);
        const int idx = (int)(L - nfull); if (idx >= 128) return false;
        const int un = idx >> 2, s = idx & 3; u.pm = S.nM + (un >> 2); u.pn = un & 3; u.kt0 = 12 * s; u.nk = (s == 3) ? 8 : 12; return true;
    }
    __device__ __forceinline__ void a_ready(const Unit&) const {}
    __device__ __forceinline__ void done(const Unit&) const {}
};
struct SplitOnlyOrder {
    int nMlat, G, c;
    __host__ __device__ void init(int Mlat, int G_, int c_) { nMlat = Mlat / BM; G = G_; c = c_; }
    __host__ __device__ bool next(int i, Unit& u) const {
        const long L = (long)i * G + c; if (L >= 128) return false;
        const int idx = (int)L, un = idx >> 2, s = idx & 3; u.pm = nMlat + (un >> 2); u.pn = un & 3; u.kt0 = 12 * s; u.nk = (s == 3) ? 8 : 12; return true;
    }
    __device__ __forceinline__ void a_ready(const Unit&) const {}
    __device__ __forceinline__ void done(const Unit&) const {}
};
__device__ __forceinline__ unsigned cvt_pk_bf16(float lo, float hi) { unsigned r; asm volatile("v_cvt_pk_bf16_f32 %0, %1, %2" : "=v"(r) : "v"(lo), "v"(hi)); return r; }
typedef float f32x2 __attribute__((ext_vector_type(2)));
__device__ __forceinline__ f32x2 gelu_pk(f32x2 v) {
    const f32x2 av = __builtin_elementwise_abs(v), d = av * 0.2316418882f + 1.0f;
    f32x2 t; t.x = __builtin_amdgcn_rcpf(d.x); t.y = __builtin_amdgcn_rcpf(d.y);
    f32x2 q = t * 0.5307027145f + (-0.7265760135f); q = q * t + 0.7107068705f; q = q * t + (-0.142248368f); q = q * t + 0.127414796f; q = q * t;
    const f32x2 s = (v * v) * (-0.72134752044f);
    f32x2 e; e.x = __builtin_amdgcn_exp2f(s.x); e.y = __builtin_amdgcn_exp2f(s.y);
    const f32x2 m = v * (q * e), r = v - m;
    f32x2 o; o.x = v.x < 0.f ? m.x : r.x; o.y = v.y < 0.f ? m.y : r.y; return o;
}

typedef unsigned u32x2 __attribute__((ext_vector_type(2)));
__device__ __forceinline__ float silu_f(float g) { return g * __builtin_amdgcn_rcpf(1.0f + __builtin_amdgcn_exp2f(-1.4426950408889634f * g)); }
struct EpiSwiglu {
    static constexpr bool PERM = true, AFTER_DRAIN = false;
    bf16_t* O; int ldo;
    __device__ __forceinline__ void operator()(const f32x4 (&acc)[2][2][4][2], const Unit& u, int wr, int wc, int fr, int fq) const {
        const int row0 = u.pm * BM + wr * 64 + fr, col0 = u.pn * HALF + wc * 32 + 8 * fq;
#pragma unroll
        for (int ai = 0; ai < 2; ++ai)
#pragma unroll
            for (int m = 0; m < 4; ++m) {
                bf16_t* p = O + (size_t)(row0 + ai * HALF + m * 16) * ldo + col0;
                const f32x4 g0 = acc[ai][0][m][0], g1 = acc[ai][0][m][1], u0 = acc[ai][1][m][0], u1 = acc[ai][1][m][1];
                u32x4 w;
                w.x = cvt_pk_bf16(silu_f(g0[0]) * u0[0], silu_f(g0[1]) * u0[1]); w.y = cvt_pk_bf16(silu_f(g0[2]) * u0[2], silu_f(g0[3]) * u0[3]);
                w.z = cvt_pk_bf16(silu_f(g1[0]) * u1[0], silu_f(g1[1]) * u1[1]); w.w = cvt_pk_bf16(silu_f(g1[2]) * u1[2], silu_f(g1[3]) * u1[3]);
                *(u32x4*)p = w;
            }
    }
};
struct EpiResid {
    static constexpr bool PERM = false, AFTER_DRAIN = false;
    const float* rlat; const float* rctx; float* out; const float* gate  ; float coef;
    __device__ __forceinline__ void operator()(const f32x4 (&acc)[2][2][4][2], const Unit& u, int wr, int wc, int fr, int fq) const {
        const bool lat = u.pm < 128; const int rix = lat ? (u.pm >> 4) : 8;
        const float* rb = lat ? rlat + (size_t)u.pm * BM * 1024 : rctx + (size_t)(u.pm - 128) * BM * 1024;
        float* ob = out + (size_t)u.pm * BM * 1024;
        const int col0 = u.pn * BM + wc * 32 + 4 * fq;
        f32x4 gv[2][2];
#pragma unroll
        for (int bj = 0; bj < 2; ++bj)
#pragma unroll
            for (int n = 0; n < 2; ++n) gv[bj][n] = *(const f32x4*)(gate + (size_t)rix * 9216 + col0 + bj * HALF + n * 16) * coef;
#pragma unroll
        for (int ai = 0; ai < 2; ++ai)
#pragma unroll
            for (int m = 0; m < 4; ++m) { const size_t off = (size_t)(ai * HALF + wr * 64 + m * 16 + fr) * 1024 + col0;
#pragma unroll
                for (int bj = 0; bj < 2; ++bj)
#pragma unroll
                    for (int n = 0; n < 2; ++n) { const f32x4 r = *(const f32x4*)(rb + off + bj * HALF + n * 16);
                        *(f32x4*)(ob + off + bj * HALF + n * 16) = r + gv[bj][n] * acc[ai][bj][m][n]; }
                if (m & 1) asm volatile("" ::: "memory"); }
    }
};
struct EpiResidS {
    static constexpr bool PERM = false, AFTER_DRAIN = false;
    const float* rlat; float* out; const float* gate; float* part;
    __device__ __forceinline__ void operator()(const f32x4 (&acc)[2][2][4][2], const Unit& u, int wr, int wc, int fr, int fq) const {
        const float* rlat_ = rlat; float* out_ = out; const float* gate_ = gate; float* part_ = part;
        const int col0 = u.pn * BM + wc * 32 + 4 * fq;
        if (u.pm >= 128) {
            float* pb = part_ + (size_t)(u.kt0 / 12) * (2048 * 1024) + (size_t)(u.pm - 128) * BM * 1024;
#pragma unroll
            for (int ai = 0; ai < 2; ++ai)
#pragma unroll
                for (int m = 0; m < 4; ++m) { const size_t off = (size_t)(ai * HALF + wr * 64 + m * 16 + fr) * 1024 + col0;
#pragma unroll
                    for (int bj = 0; bj < 2; ++bj)
#pragma unroll
                        for (int n = 0; n < 2; ++n) *(f32x4*)(pb + off + bj * HALF + n * 16) = acc[ai][bj][m][n]; }
            return;
        }
        const int rix = u.pm >> 4;
        const float* rb = rlat_ + (size_t)u.pm * BM * 1024; float* ob = out_ + (size_t)u.pm * BM * 1024;
        f32x4 gv[2][2];
#pragma unroll
        for (int bj = 0; bj < 2; ++bj)
#pragma unroll
            for (int n = 0; n < 2; ++n) gv[bj][n] = *(const f32x4*)(gate_ + (size_t)rix * 9216 + col0 + bj * HALF + n * 16) * 0.5f;
#pragma unroll
        for (int ai = 0; ai < 2; ++ai)
#pragma unroll
            for (int m = 0; m < 4; ++m) { const size_t off = (size_t)(ai * HALF + wr * 64 + m * 16 + fr) * 1024 + col0;
#pragma unroll
                for (int bj = 0; bj < 2; ++bj)
#pragma unroll
                    for (int n = 0; n < 2; ++n) { const f32x4 r = *(const f32x4*)(rb + off + bj * HALF + n * 16);
                        *(f32x4*)(ob + off + bj * HALF + n * 16) = r + gv[bj][n] * acc[ai][bj][m][n]; }
                if (m & 1) asm volatile("" ::: "memory"); }
    }
};
template <int COEF2, bool FINAL> struct EpiResidRms {
    static constexpr bool PERM = false, AFTER_DRAIN = false;
    const float* resid; float* xout; const float* gate; const float* g; const float* scm; const float* shm; bf16_t* hn; float* part; unsigned* cnt; PG8_LAS float* tab; float* splitpart  ;
    __device__ __forceinline__ void operator()(const f32x4 (&acc_c)[2][2][4][2], const Unit& u, int wr, int wc, int fr_in, int fq_in) const {
        f32x4 (&acc)[2][2][4][2] = const_cast<f32x4 (&)[2][2][4][2]>(acc_c);
        int fr = fr_in, fq = fq_in; asm volatile("" : "+v"(fr), "+v"(fq));
        if (splitpart != nullptr && u.pm >= 128) {
            float* sb = splitpart + (size_t)(u.kt0 / 12) * (2048 * 1024) + (size_t)(u.pm - 128) * BM * 1024; const int c0 = u.pn * BM + wc * 32 + 4 * fq;
#pragma unroll
            for (int ai = 0; ai < 2; ++ai)
#pragma unroll
                for (int m = 0; m < 4; ++m) { const size_t off = (size_t)(ai * HALF + wr * 64 + m * 16 + fr) * 1024 + c0;
#pragma unroll
                    for (int bj = 0; bj < 2; ++bj)
#pragma unroll
                        for (int n = 0; n < 2; ++n) *(f32x4*)(sb + off + bj * HALF + n * 16) = acc[ai][bj][m][n]; }
            return;
        }
        const float* resid_ = resid; float* xout_ = xout; const float* gate_ = gate; const float* g_ = g; const float* scm_ = scm; const float* shm_ = shm; bf16_t* hn_ = hn; float* part_ = part; unsigned* cnt_ = cnt; PG8_LAS float* tab_ = tab;
        const int rix = u.pm >> 4, col0 = u.pn * BM + wc * 32 + 4 * fq, wid = wr * 4 + wc, lane = fq * 16 + fr, tid = wid * 64 + lane;
        const float* rb = resid_ + (size_t)u.pm * BM * 1024; float* pb = part_ + (size_t)u.pm * BM * 16 + u.pn * 4 + wc;
        PG8_LAS float* vec = tab_ + 384; const int cl = wc * 32 + 4 * fq;
        if (tid < 256) { const int c = u.pn * BM + tid; vec[tid] = gate_[(size_t)rix * 9216 + c] * (0.5f * COEF2);
            if (FINAL) vec[256 + tid] = g_[c]; else { vec[256 + tid] = g_[c] * (scm_[(size_t)rix * 9216 + c] + 1.0f); vec[512 + tid] = shm_[(size_t)rix * 9216 + c]; } }
        asm volatile("s_waitcnt vmcnt(0) lgkmcnt(0)" ::: "memory"); __builtin_amdgcn_s_barrier(); asm volatile("" ::: "memory");
        {
#pragma unroll
          for (int ap = 0; ap < 4; ++ap) { const int ai = ap >> 1, m0 = (ap & 1) * 2; f32x4 rr[2][2][2];
              asm volatile("" ::: "memory");
#pragma unroll
              for (int mm = 0; mm < 2; ++mm) { const size_t off = (size_t)(ai * HALF + wr * 64 + (m0 + mm) * 16 + fr) * 1024 + col0;
#pragma unroll
                  for (int bj = 0; bj < 2; ++bj)
#pragma unroll
                      for (int n = 0; n < 2; ++n) rr[mm][bj][n] = __builtin_nontemporal_load((const f32x4*)(rb + off + bj * HALF + n * 16)); }
#pragma unroll
              for (int mm = 0; mm < 2; ++mm) { const int m = m0 + mm, rl = ai * HALF + wr * 64 + m * 16 + fr; float ss = 0.f;
#pragma unroll
                  for (int bj = 0; bj < 2; ++bj)
#pragma unroll
                      for (int n = 0; n < 2; ++n) { const f32x4 gv = *(const PG8_LAS f32x4*)(vec + cl + bj * HALF + n * 16); const f32x4 o = rr[mm][bj][n] + gv * acc[ai][bj][m][n];
                          acc[ai][bj][m][n] = o; ss += (o[0] * o[0] + o[1] * o[1]) + (o[2] * o[2] + o[3] * o[3]); }
                  ss += __shfl_xor(ss, 16); ss += __shfl_xor(ss, 32);
                  if (fq == 0) __hip_atomic_store(pb + (size_t)rl * 16, ss, __ATOMIC_RELAXED, __HIP_MEMORY_SCOPE_AGENT); } } }
        asm volatile("s_waitcnt vmcnt(0)" ::: "memory");
        unsigned* cw = cnt_ + 64 * u.pm;
        if (lane == 0) __hip_atomic_fetch_add(cw, 1u, __ATOMIC_RELAXED, __HIP_MEMORY_SCOPE_AGENT);
        if (wid == 0) { unsigned sp = 0;
            while ((unsigned)__builtin_amdgcn_readfirstlane(__hip_atomic_load(cw, __ATOMIC_RELAXED, __HIP_MEMORY_SCOPE_AGENT)) < 32u) { __builtin_amdgcn_s_sleep(2); if (++sp > (1u << 22)) break; } }
        asm volatile("s_waitcnt vmcnt(0) lgkmcnt(0)" ::: "memory"); __builtin_amdgcn_s_barrier(); asm volatile("" ::: "memory");
        if (tid < 256) { const unsigned long long* pp = (const unsigned long long*)(part_ + ((size_t)u.pm * BM + tid) * 16); float s = 0.f;
#pragma unroll
            for (int q = 0; q < 8; ++q) { const unsigned long long w = __hip_atomic_load(pp + q, __ATOMIC_RELAXED, __HIP_MEMORY_SCOPE_AGENT); s += __uint_as_float((unsigned)w) + __uint_as_float((unsigned)(w >> 32)); }
            tab_[tid] = 1.0f / sqrtf(s * (1.0f / 1024.0f) + 1e-6f); }
        asm volatile("s_waitcnt vmcnt(0) lgkmcnt(0)" ::: "memory"); __builtin_amdgcn_s_barrier(); asm volatile("" ::: "memory");
        { float* ob = xout_ + (size_t)u.pm * BM * 1024; bf16_t* hb = hn_ + (size_t)u.pm * BM * 1024;
#pragma unroll
          for (int ai = 0; ai < 2; ++ai)
#pragma unroll
            for (int m = 0; m < 4; ++m) { const int rl = ai * HALF + wr * 64 + m * 16 + fr; const size_t off = (size_t)rl * 1024 + col0; const float rs = tab_[rl];
#pragma unroll
                for (int bj = 0; bj < 2; ++bj)
#pragma unroll
                    for (int n = 0; n < 2; ++n) { const f32x4 gs = *(const PG8_LAS f32x4*)(vec + 256 + cl + bj * HALF + n * 16); const f32x4 o = acc[ai][bj][m][n];
                        if (FINAL) __builtin_nontemporal_store(o * rs * gs, (f32x4*)(ob + off + bj * HALF + n * 16));
                        else { const f32x4 sh = *(const PG8_LAS f32x4*)(vec + 512 + cl + bj * HALF + n * 16);
                               *(f32x4*)(ob + off + bj * HALF + n * 16) = o; const f32x4 a = o * rs * gs + sh; u32x2 w; w.x = cvt_pk_bf16(a[0], a[1]); w.y = cvt_pk_bf16(a[2], a[3]); *(u32x2*)(hb + off + bj * HALF + n * 16) = w; } } }
        }
        asm volatile("s_waitcnt lgkmcnt(0)" ::: "memory"); __builtin_amdgcn_s_barrier(); asm volatile("" ::: "memory");
    }
};
struct EpiSplitRaw {
    static constexpr bool PERM = false, AFTER_DRAIN = false;
    float* part;
    __device__ __forceinline__ void operator()(const f32x4 (&acc)[2][2][4][2], const Unit& u, int wr, int wc, int fr, int fq) const {
        float* sb = part + (size_t)(u.kt0 / 12) * (2048 * 1024) + (size_t)(u.pm - 128) * BM * 1024; const int c0 = u.pn * BM + wc * 32 + 4 * fq;
#pragma unroll
        for (int ai = 0; ai < 2; ++ai)
#pragma unroll
            for (int m = 0; m < 4; ++m) { const size_t off = (size_t)(ai * HALF + wr * 64 + m * 16 + fr) * 1024 + c0;
#pragma unroll
                for (int bj = 0; bj < 2; ++bj)
#pragma unroll
                    for (int n = 0; n < 2; ++n) *(f32x4*)(sb + off + bj * HALF + n * 16) = acc[ai][bj][m][n]; }
    }
};
struct EpiInproj {
    static constexpr bool PERM = false, AFTER_DRAIN = false;
    bf16_t* HQ; bf16_t* KP; bf16_t* VP; float qs;
    __device__ __forceinline__ void operator()(const f32x4 (&acc)[2][2][4][2], const Unit& u, int wr, int wc, int fr, int fq) const {
        const int tt = u.pn >> 1; const bool lat = u.pm < 128; const bool rope = (tt < 2) && lat;
        const int row0 = u.pm * BM + wr * 64 + fr, cw = wc * 32 + 4 * fq;
        float fr4[4];
#pragma unroll
        for (int e = 0; e < 4; ++e) fr4[e] = __builtin_amdgcn_exp2f(-(float)(4 * fq + e) * (13.287712379549449f / 16.0f)) * 0.15915494309189535f;
        const float sc = (tt == 0) ? qs : 1.0f;
#pragma unroll
        for (int ai = 0; ai < 2; ++ai)
#pragma unroll
            for (int m = 0; m < 4; ++m) { const int row = row0 + ai * HALF + m * 16;
                bf16_t* p;
                if (tt == 0) p = HQ + (size_t)row * 512 + (u.pn & 1) * 256 + cw;
                else if (tt == 3) p = HQ + (size_t)34816 * 512 + ((size_t)((u.pn & 1) * 2) * 34816 + row) * 128 + cw;
                else { const int b = lat ? (row >> 12) : ((row - 32768) >> 8), kv = lat ? (row & 4095) : 4096 + ((row - 32768) & 255);
                       p = (tt == 1 ? KP : VP) + ((size_t)(b * 4 + (u.pn & 1) * 2) * 4352 + kv) * 128 + cw; }
                const size_t bjs = (tt == 0) ? (size_t)HALF : (tt == 3) ? (size_t)34816 * 128 : (size_t)4352 * 128;
                float cs[4], sn[4];
                if (rope) { const int t = row & 4095; const float pos = (float)((wc & 1) ? (t & 63) : (t >> 6));
#pragma unroll
                    for (int e = 0; e < 4; ++e) { const float rev = __builtin_amdgcn_fractf(pos * fr4[e]); cs[e] = __builtin_amdgcn_cosf(rev) * sc; sn[e] = __builtin_amdgcn_sinf(rev) * sc; } }
                else {
#pragma unroll
                    for (int e = 0; e < 4; ++e) { cs[e] = sc; sn[e] = 0.f; } }
#pragma unroll
                for (int bj = 0; bj < 2; ++bj) { const f32x4 a0 = acc[ai][bj][m][0], a1 = acc[ai][bj][m][1]; float o0[4], o1[4];
#pragma unroll
                    for (int e = 0; e < 4; ++e) { o0[e] = a0[e] * cs[e] - a1[e] * sn[e]; o1[e] = a1[e] * cs[e] + a0[e] * sn[e]; }
                    u32x2 w0, w1; w0.x = cvt_pk_bf16(o0[0], o0[1]); w0.y = cvt_pk_bf16(o0[2], o0[3]); w1.x = cvt_pk_bf16(o1[0], o1[1]); w1.y = cvt_pk_bf16(o1[2], o1[3]);
                    *(u32x2*)(p + bj * bjs) = w0; *(u32x2*)(p + bj * bjs + 16) = w1; }
            }
    }
};
template <class Epi, class Sched, bool ALIGN_EPI = false, bool SP2 = false>
__device__ __forceinline__ void gemm_phase(PG8_LAS unsigned char* lds, const Gemm g, const Sched& S, const Epi& E) {
    int tid_l = threadIdx.x; asm volatile("" : "+v"(tid_l));
    const int tid = tid_l, wid = __builtin_amdgcn_readfirstlane(tid >> 6), lane = tid & 63, wr = wid >> 2, wc = wid & 3, fr = lane & 15, fq = lane >> 4;
    const int K = g.K; int nt = 0;
    unsigned voffA[2], voffB[2];
#pragma unroll
    for (int i = 0; i < 2; ++i) { int R, C; stage_rc(tid * 16 + i * 8192, R, C); const int Rb = Epi::PERM ? ((R & ~31) + perm32(R & 31)) : R;
        voffA[i] = (unsigned)(R * K + C) * 2u; voffB[i] = (unsigned)(Rb * K + C) * 2u; }
    const size_t kstep = (size_t)(BK * 2);
    const size_t hstep = (size_t)HALF * K * 2;
    const size_t tstep = 2 * hstep;
    const unsigned ldsw = (unsigned)wid * 1024u;
    const int aoff = lds_byte(wr * 64 + fr, fq * 8), boff = lds_byte(wc * 32 + fr, fq * 8);
#define PG8_SA(b, h) (((b) * 2 + (h)) * HTB)
#define PG8_SB(b, h) ((4 + (b) * 2 + (h)) * HTB)
#define PG8_STAGE(bufoff, gbase, voff) do { _Pragma("unroll") for (int _i = 0; _i < 2; ++_i) \
        __builtin_amdgcn_global_load_lds((const unsigned*)((const char*)(gbase) + (voff)[_i]), (PG8_LAS unsigned*)(lds + (bufoff) + ldsw + _i * 8192), 16, 0, 0); } while (0)
#define PG8_LDA(dst, b, h) do { _Pragma("unroll") for (int m = 0; m < 4; ++m) _Pragma("unroll") for (int k = 0; k < 2; ++k) dst[m][k] = *(const PG8_LAS bf16x8*)(lds + PG8_SA(b, h) + aoff + m * 2048 + k * 1024); } while (0)
#define PG8_LDB(dst, b, h) do { _Pragma("unroll") for (int n = 0; n < 2; ++n) _Pragma("unroll") for (int k = 0; k < 2; ++k) dst[n][k] = *(const PG8_LAS bf16x8*)(lds + PG8_SB(b, h) + boff + n * 2048 + k * 1024); } while (0)
#define PG8_MMA(ai, bj, At, Bt) do { __builtin_amdgcn_s_setprio(1); _Pragma("unroll") for (int m = 0; m < 4; ++m) _Pragma("unroll") for (int n = 0; n < 2; ++n) _Pragma("unroll") for (int k = 0; k < 2; ++k) \
        acc[ai][bj][m][n] = __builtin_amdgcn_mfma_f32_16x16x32_bf16(Bt[n][k], At[m][k], acc[ai][bj][m][n], 0, 0, 0); __builtin_amdgcn_s_setprio(0); } while (0)
#define PG8_WAIT_V(n) asm volatile("s_waitcnt vmcnt(" #n ")" ::: "memory")
#define PG8_WAIT_L(n) asm volatile("s_waitcnt lgkmcnt(" #n ")" ::: "memory")
#define PG8_BAR __builtin_amdgcn_s_barrier()
#define PG8_SCHED __builtin_amdgcn_sched_barrier(0)
    Unit cur, nxt; int ui = 0;
    if (!S.next(0, cur)) return;
    f32x4 acc[2][2][4][2];
#pragma unroll
    for (int a = 0; a < 2; ++a)
#pragma unroll
        for (int b = 0; b < 2; ++b)
#pragma unroll
            for (int m = 0; m < 4; ++m)
#pragma unroll
                for (int n = 0; n < 2; ++n) acc[a][b][m][n] = (f32x4){0.f, 0.f, 0.f, 0.f};
    bf16x8 At[4][2], B0[2][2], B1[2][2];
    nt = cur.nk;
    const char* cA = (const char*)g.A + (size_t)cur.pm * tstep + (size_t)cur.kt0 * kstep; const char* cB = (const char*)g.Bt + (size_t)cur.pn * tstep + (size_t)cur.kt0 * kstep;
    S.a_ready(cur);
    if constexpr (SP2) {
        PG8_STAGE(PG8_SB(0, 0), cB, voffB); PG8_STAGE(PG8_SB(0, 1), cB + hstep, voffB); PG8_STAGE(PG8_SA(0, 0), cA, voffA); PG8_STAGE(PG8_SA(0, 1), cA + hstep, voffA);
        if (wr == 1) PG8_BAR;
        PG8_WAIT_V(2); PG8_BAR;
        PG8_STAGE(PG8_SB(1, 0), cB + kstep, voffB); PG8_STAGE(PG8_SA(1, 0), cA + kstep, voffA); PG8_STAGE(PG8_SB(1, 1), cB + hstep + kstep, voffB);
        PG8_WAIT_V(6); PG8_BAR;
    } else {
        PG8_STAGE(PG8_SB(0, 0), cB, voffB); PG8_STAGE(PG8_SA(0, 0), cA, voffA); PG8_STAGE(PG8_SB(0, 1), cB + hstep, voffB); PG8_STAGE(PG8_SA(0, 1), cA + hstep, voffA);
        if (wr == 1) PG8_BAR;
        PG8_WAIT_V(4); PG8_BAR;
        PG8_STAGE(PG8_SB(1, 0), cB + kstep, voffB); PG8_STAGE(PG8_SA(1, 0), cA + kstep, voffA); PG8_STAGE(PG8_SB(1, 1), cB + hstep + kstep, voffB);
        PG8_WAIT_V(6); PG8_BAR;
    }
    for (;;) {
        const bool has_next = S.next(ui + 1, nxt);
        const char* nA = has_next ? (const char*)g.A + (size_t)nxt.pm * tstep + (size_t)nxt.kt0 * kstep : cA; const char* nB = has_next ? (const char*)g.Bt + (size_t)nxt.pn * tstep + (size_t)nxt.kt0 * kstep : cB;
        for (int t = 0; t < nt; t += 2) {
            const bool last = (t == nt - 2);
            const char* a1 = cA + (size_t)(t + 1) * kstep;
            const char* a2 = last ? nA : cA + (size_t)(t + 2) * kstep; const char* b2 = last ? nB : cB + (size_t)(t + 2) * kstep;
            const char* a3 = a2 + kstep; const char* b3 = b2 + kstep;
            if (last && has_next) S.a_ready(nxt);
            if constexpr (SP2) {
            PG8_LDB(B0, 0, 0); PG8_LDB(B1, 0, 1); PG8_SCHED; PG8_LDA(At, 0, 0); PG8_STAGE(PG8_SA(1, 1), a1 + hstep, voffA);
            PG8_WAIT_V(8); PG8_WAIT_L(0); PG8_BAR; PG8_MMA(0, 0, At, B0); PG8_MMA(0, 1, At, B1); PG8_BAR; PG8_SCHED;
            PG8_LDA(At, 0, 1); PG8_STAGE(PG8_SB(0, 0), b2, voffB); PG8_STAGE(PG8_SB(0, 1), b2 + hstep, voffB); PG8_STAGE(PG8_SA(0, 0), a2, voffA);
            PG8_WAIT_V(8); PG8_WAIT_L(0); PG8_BAR; PG8_MMA(1, 0, At, B0); PG8_MMA(1, 1, At, B1); PG8_BAR; PG8_SCHED;
            PG8_LDB(B0, 1, 0); PG8_LDB(B1, 1, 1); PG8_SCHED; PG8_LDA(At, 1, 0); PG8_STAGE(PG8_SA(0, 1), a2 + hstep, voffA);
            PG8_WAIT_V(8); PG8_WAIT_L(0); PG8_BAR; PG8_MMA(0, 0, At, B0); PG8_MMA(0, 1, At, B1); PG8_BAR; PG8_SCHED;
            PG8_LDA(At, 1, 1); PG8_STAGE(PG8_SB(1, 0), b3, voffB); PG8_STAGE(PG8_SB(1, 1), b3 + hstep, voffB); PG8_STAGE(PG8_SA(1, 0), a3, voffA);
            PG8_WAIT_V(8); PG8_WAIT_L(0); PG8_BAR; PG8_MMA(1, 0, At, B0); PG8_MMA(1, 1, At, B1); PG8_BAR; PG8_SCHED;
            } else {
            PG8_LDB(B0, 0, 0); PG8_SCHED; PG8_LDA(At, 0, 0); PG8_STAGE(PG8_SA(1, 1), a1 + hstep, voffA);
            PG8_WAIT_L(8); PG8_BAR; PG8_WAIT_L(0); PG8_MMA(0, 0, At, B0); PG8_BAR; PG8_SCHED;
            PG8_LDB(B1, 0, 1); PG8_STAGE(PG8_SB(0, 0), b2, voffB);
            PG8_BAR; PG8_WAIT_L(0); PG8_MMA(0, 1, At, B1); PG8_BAR;
            PG8_LDA(At, 0, 1); PG8_STAGE(PG8_SA(0, 0), a2, voffA);
            PG8_BAR; PG8_WAIT_L(0); PG8_MMA(1, 0, At, B0); PG8_BAR; PG8_SCHED;
            PG8_STAGE(PG8_SB(0, 1), b2 + hstep, voffB);
            PG8_WAIT_V(6); PG8_BAR; PG8_MMA(1, 1, At, B1); PG8_BAR;
            PG8_LDB(B0, 1, 0); PG8_SCHED; PG8_LDA(At, 1, 0); PG8_STAGE(PG8_SA(0, 1), a2 + hstep, voffA);
            PG8_WAIT_L(8); PG8_BAR; PG8_WAIT_L(0); PG8_MMA(0, 0, At, B0); PG8_BAR; PG8_SCHED;
            PG8_LDB(B1, 1, 1); PG8_STAGE(PG8_SB(1, 0), b3, voffB);
            PG8_BAR; PG8_WAIT_L(0); PG8_MMA(0, 1, At, B1); PG8_BAR;
            PG8_LDA(At, 1, 1); PG8_STAGE(PG8_SA(1, 0), a3, voffA);
            PG8_BAR; PG8_WAIT_L(0); PG8_MMA(1, 0, At, B0); PG8_BAR; PG8_SCHED;
            PG8_STAGE(PG8_SB(1, 1), b3 + hstep, voffB);
            PG8_WAIT_V(6); PG8_BAR; PG8_MMA(1, 1, At, B1); PG8_BAR;
            }
        }
        if constexpr (ALIGN_EPI) { if (wr == 0) PG8_BAR; }
        if constexpr (!Epi::AFTER_DRAIN) { E(acc, cur, wr, wc, fr, fq); S.done(cur); }
        if (!has_next) break;
#pragma unroll
        for (int a = 0; a < 2; ++a)
#pragma unroll
            for (int b = 0; b < 2; ++b)
#pragma unroll
                for (int m = 0; m < 4; ++m)
#pragma unroll
                    for (int n = 0; n < 2; ++n) acc[a][b][m][n] = (f32x4){0.f, 0.f, 0.f, 0.f};
        cur = nxt; cA = nA; cB = nB; ++ui; nt = cur.nk;
        if constexpr (ALIGN_EPI) { if (wr == 1) PG8_BAR; }
    }
    PG8_WAIT_V(0);
    if constexpr (!ALIGN_EPI) { if (wr == 0) PG8_BAR; }
    PG8_BAR;
    if constexpr (Epi::AFTER_DRAIN) { E.fused(acc, cur, wr, wc, fr, fq, lds, wid, lane); S.done(cur); }
#undef PG8_SA
#undef PG8_SB
#undef PG8_STAGE
#undef PG8_LDA
#undef PG8_LDB
#undef PG8_MMA
#undef PG8_WAIT_V
#undef PG8_WAIT_L
#undef PG8_BAR
#undef PG8_SCHED
}
}

#include <hip/hip_cooperative_groups.h>
namespace cg = cooperative_groups;
#define LAS __attribute__((address_space(3)))
typedef unsigned short bf16;
typedef unsigned u32x4 __attribute__((ext_vector_type(4)));
typedef unsigned u32x2 __attribute__((ext_vector_type(2)));
typedef float f32x4 __attribute__((ext_vector_type(4)));
typedef float f32x16 __attribute__((ext_vector_type(16)));
typedef short bf16x8 __attribute__((ext_vector_type(8)));
typedef short s16x4 __attribute__((ext_vector_type(4)));

constexpr int D = 1024, NB = 8, SEQ = 4096, CTX = 256, DFF = 2816, NLAT = NB * SEQ  , NTOK = NLAT + NB * CTX  , INW = 2048, NMOD = 9 * D;
constexpr float EPS = 1e-6f, QSCALE = 0.125f * 1.4426950408889634f, LAM_INIT = 0.2f;
constexpr size_t MiB = 1u << 20;
constexpr size_t WS_BAR = 512 * 1024, WS_MOD = 0, WS_W1A = 1 * MiB, WS_W2A = 12 * MiB, WS_W1B = 18 * MiB, WS_W2B = 29 * MiB, WS_WIN = 35 * MiB, WS_WOUT = 39 * MiB, WS_WP = 41 * MiB,
                 WS_HN = 48 * MiB, WS_X1 = 116 * MiB, WS_BIG = 252 * MiB, WS_END = 440 * MiB;
static_assert(WS_HN + (size_t)NTOK * D * 2 <= WS_X1 && WS_X1 + (size_t)NTOK * D * 4 <= WS_BIG && WS_BIG + (size_t)NTOK * DFF * 2 <= WS_END, "ws map");
constexpr int LDS_BYTES = 147456, NWAVES = 8, NPHASE = 12;
#ifndef MK_N_LAUNCHES
#define MK_N_LAUNCHES 1
#endif

__device__ __forceinline__ unsigned f2bf(float f) { unsigned u = __builtin_bit_cast(unsigned, f); return (u + 0x7fffu + ((u >> 16) & 1u)) >> 16; }
__device__ __forceinline__ unsigned pk2(float lo, float hi) { return f2bf(lo) | (f2bf(hi) << 16); }
__device__ __forceinline__ unsigned cvtpk(float lo, float hi) { unsigned r; asm volatile("v_cvt_pk_bf16_f32 %0, %1, %2" : "=v"(r) : "v"(lo), "v"(hi)); return r; }
__device__ __forceinline__ float bflo(unsigned w) { return __builtin_bit_cast(float, w << 16); }
__device__ __forceinline__ float bfhi(unsigned w) { return __builtin_bit_cast(float, w & 0xffff0000u); }
__device__ __forceinline__ float wave_sum(float v) {
#pragma unroll
    for (int o = 1; o < 64; o <<= 1) v += __shfl_xor(v, o);
    return v;
}
__device__ __forceinline__ int crow(int r, int hi) { return (r & 3) + 8 * (r >> 2) + 4 * hi; }

__device__ __forceinline__ void adaln_unit(LAS unsigned char* lds, int unit, const float* c, const float* c_ctx, const float* w_mod, const float* b_mod, float* mod, int tid) {
    LAS float* scond = (LAS float*)lds;
    LAS float* part = (LAS float*)(lds + 36864);
    for (int i = tid; i < 9 * D; i += 512) { const int r = i >> 10, k = i & 1023; const float v = (r < 8) ? c[r * D + k] : c_ctx[k]; scond[i] = v / (1.0f + __expf(-v)); }
    __syncthreads();
    const int cgp = tid & 15, ks = tid >> 4;
    f32x4 acc[9];
#pragma unroll
    for (int r = 0; r < 9; ++r) acc[r] = (f32x4){0.f, 0.f, 0.f, 0.f};
    const float* wp = w_mod + (size_t)(32 * ks) * NMOD + 64 * unit + 4 * cgp;
#pragma unroll 8
    for (int kk = 0; kk < 32; ++kk) { const f32x4 w = *(const f32x4*)(wp + (size_t)kk * NMOD);
#pragma unroll
        for (int r = 0; r < 9; ++r) acc[r] += w * scond[r * D + 32 * ks + kk]; }
#pragma unroll
    for (int r = 0; r < 9; ++r) *(LAS f32x4*)(part + (ks * 9 + r) * 64 + 4 * cgp) = acc[r];
    __syncthreads();
    for (int o = tid; o < 9 * 64; o += 512) { const int r = o >> 6, cc = o & 63; float s = 0.f;
#pragma unroll 8
        for (int k2 = 0; k2 < 32; ++k2) s += part[(k2 * 9 + r) * 64 + cc];
        mod[(size_t)r * NMOD + 64 * unit + cc] = s + b_mod[64 * unit + cc]; }
    __syncthreads();
}
__device__ __forceinline__ void transpose_item(const float* W, int ldw, bf16* WT, int ldt, int k0, int n0, int drow0, LAS float* scr, int lane) {
#pragma unroll 8
    for (int i = 0; i < 32; ++i) { const int kk = 2 * i + (lane >> 5); scr[kk * 33 + (lane & 31)] = W[(size_t)(k0 + kk) * ldw + n0 + (lane & 31)]; }
    asm volatile("s_waitcnt lgkmcnt(0)" ::: "memory");
    const int c = lane & 7;
#pragma unroll
    for (int j = 0; j < 4; ++j) { const int n = (lane >> 3) + 8 * j; const LAS float* s = scr + (8 * c) * 33 + n;
        u32x4 o; o.x = pk2(s[0 * 33], s[1 * 33]); o.y = pk2(s[2 * 33], s[3 * 33]); o.z = pk2(s[4 * 33], s[5 * 33]); o.w = pk2(s[6 * 33], s[7 * 33]);
        *(u32x4*)(WT + (size_t)(drow0 + n) * ldt + k0 + 8 * c) = o; }
    asm volatile("s_waitcnt lgkmcnt(0)" ::: "memory");
}
__device__ __forceinline__ void transpose_mat_item(const float* W, int K, int N, bf16* WT, bool swiglu, int item, LAS float* scr, int lane) {
    const int nblk = N / 32, kb = item / nblk, nb = item % nblk, n0 = 32 * nb; int drow0 = n0;
    if (swiglu) { const int half = N / 2; const int j = (n0 < half) ? n0 : n0 - half; drow0 = (j >> 7) * 256 + ((n0 < half) ? 0 : 128) + (j & 127); }
    transpose_item(W, N, WT, K, 64 * kb, n0, drow0, scr, lane);
}

__device__ __forceinline__ void norm_pass(const float* lat, const float* ctxp, int nrows, const float* g, const float* mod, int sh_i, int sc_i, bf16* dst, float* dstf, int wave, int lane, const float* part = nullptr, const float* pgate = nullptr, int row_begin = 0) {
    const int gw = blockIdx.x * NWAVES + wave, NGW = gridDim.x * NWAVES, nch = nrows >> 2;
    for (int ch = gw + (row_begin >> 2); ch < nch; ch += NGW) {
        const int row0 = ch * 4; const bool isl = row0 < NLAT; const int rix = isl ? (row0 >> 12) : 8;
        const float* src = isl ? lat + (size_t)row0 * D : ctxp + (size_t)(row0 - NLAT) * D;
        f32x4 gs[4], sh[4];
#pragma unroll
        for (int j = 0; j < 4; ++j) { const int col = 4 * lane + 256 * j; gs[j] = *(const f32x4*)(g + col);
            if (mod) { gs[j] = gs[j] * (*(const f32x4*)(mod + (size_t)rix * NMOD + sc_i * D + col) + 1.0f); sh[j] = *(const f32x4*)(mod + (size_t)rix * NMOD + sh_i * D + col); }
            else sh[j] = (f32x4){0.f, 0.f, 0.f, 0.f}; }
#pragma unroll
        for (int rr = 0; rr < 4; ++rr) {
            f32x4 v[4]; float ss = 0.f;
#pragma unroll
            for (int j = 0; j < 4; ++j) { v[j] = __builtin_nontemporal_load((const f32x4*)(src + (size_t)rr * D + 4 * lane + 256 * j));
                if (part && !isl) { const float* pp = part + (size_t)(row0 - NLAT + rr) * D + 4 * lane + 256 * j; const size_t ps = (size_t)2048 * 1024;
                    const f32x4 sp = (*(const f32x4*)pp + *(const f32x4*)(pp + ps)) + (*(const f32x4*)(pp + 2 * ps) + *(const f32x4*)(pp + 3 * ps));
                    v[j] = v[j] + sp * (*(const f32x4*)(pgate + 4 * lane + 256 * j) * 0.5f); }
                ss += (v[j].x * v[j].x + v[j].y * v[j].y) + (v[j].z * v[j].z + v[j].w * v[j].w); }
            const float rstd = 1.0f / sqrtf(wave_sum(ss) * (1.0f / D) + EPS);
#pragma unroll
            for (int j = 0; j < 4; ++j) { const f32x4 o = v[j] * rstd * gs[j] + sh[j]; const size_t off = (size_t)(row0 + rr) * D + 4 * lane + 256 * j;
                if (dstf) __builtin_nontemporal_store(o, (f32x4*)(dstf + off));
                else { u32x2 w; w.x = pk2(o.x, o.y); w.y = pk2(o.z, o.w); *(u32x2*)(dst + off) = w; } }
        }
    }
}

constexpr int PU_STRIDE = 320, PU_ROWS = 144, PO_OFF = PU_ROWS * PU_STRIDE  , PW_OFF = PO_OFF + 128 * 272  ;
__device__ __forceinline__ bf16x8 pfrag(const LAS unsigned char* p) { const s16x4 vl = __builtin_bit_cast(s16x4, __builtin_amdgcn_ds_read_tr16_b64_v4i16((LAS s16x4*)p)), vh = __builtin_bit_cast(s16x4, __builtin_amdgcn_ds_read_tr16_b64_v4i16((LAS s16x4*)(p + 8 * PU_STRIDE)));
    return (bf16x8){vl[0], vl[1], vl[2], vl[3], vh[0], vh[1], vh[2], vh[3]}; }
__device__ __forceinline__ void pool_load(int rb, int gi, const bf16* HX, const bf16* WPt, u32x4 (&v)[5], u32x4 (&wv)[4], int tid) {
    const int b = rb >> 5, t0 = (rb & 31) * 128;
#pragma unroll
    for (int k = 0; k < 5; ++k) { const int cidx = tid + 512 * k, i = cidx >> 4, ch = cidx & 15, t = t0 - 8 + i; v[k] = (u32x4){0u, 0u, 0u, 0u};
        if (cidx < PU_ROWS * 16 && t >= 0 && t < SEQ) v[k] = *(const u32x4*)(HX + (size_t)NTOK * 512 + ((size_t)gi * NTOK + (size_t)b * SEQ + t) * 128 + ch * 8); }
#pragma unroll
    for (int k = 0; k < 4; ++k) { const int cidx = tid + 512 * k; wv[k] = *(const u32x4*)(WPt + (size_t)gi * 128 * 128 + cidx * 8); }
}
__device__ __forceinline__ void pool_stage(LAS unsigned char* lds, const u32x4 (&v)[5], const u32x4 (&wv)[4], int tid) {
#pragma unroll
    for (int k = 0; k < 5; ++k) { const int cidx = tid + 512 * k, i = cidx >> 4, ch = cidx & 15; if (cidx < PU_ROWS * 16) *(LAS u32x4*)(lds + i * PU_STRIDE + ch * 16) = v[k]; }
#pragma unroll
    for (int k = 0; k < 4; ++k) { const int cidx = tid + 512 * k, n = cidx >> 4, ch = cidx & 15; *(LAS u32x4*)(lds + PW_OFF + n * 272 + ch * 16) = wv[k]; }
}
__device__ __forceinline__ void pool_compute(LAS unsigned char* lds, int rb, int gi, const float* pool_scale, bf16* MIX, int tid, int wave, int lane) {
    const int b = rb >> 5, t0 = (rb & 31) * 128, lo = 1 << gi;
    const int r32 = lane & 31, hi = lane >> 5, tb = wave & 3, half = wave >> 2;
    f32x16 acc[4]; acc[0] = f32x16{}; acc[1] = f32x16{}; acc[2] = f32x16{}; acc[3] = f32x16{};
    { const LAS unsigned char* ub = lds + (4 * hi + ((lane & 15) >> 2)) * PU_STRIDE + (16 * ((lane >> 4) & 1) + 4 * (lane & 3)) * 2;
#pragma unroll
      for (int ksl = 0; ksl < 3; ++ksl) { const int ks = 2 * tb + ksl;
          u32x4 bw;
#pragma unroll
          for (int jj = 0; jj < 4; ++jj) { const int j0 = 2 * jj, j1 = 2 * jj + 1;
              const int d0 = 16 * ks + 4 * hi + (j0 & 3) + 8 * (j0 >> 2) - 8 - (32 * tb + r32), d1 = 16 * ks + 4 * hi + (j1 & 3) + 8 * (j1 >> 2) - 8 - (32 * tb + r32);
              bw[jj] = ((d0 >= -lo && d0 < lo) ? 0x3F80u : 0u) | ((d1 >= -lo && d1 < lo) ? 0x3F800000u : 0u); }
          const bf16x8 bfr = __builtin_bit_cast(bf16x8, bw);
#pragma unroll
          for (int cb = 0; cb < 4; ++cb) acc[cb] = __builtin_amdgcn_mfma_f32_32x32x16_bf16(pfrag(ub + ks * 16 * PU_STRIDE + cb * 64), bfr, acc[cb], 0, 0, 0); } }
    bf16x8 dfr[8];
    { const int t = t0 + 32 * tb + r32; const int st = (t - lo > 0) ? t - lo : 0, en = (t + lo - 1 < SEQ - 1) ? t + lo - 1 : SEQ - 1; const float inv = 1.0f / (float)(en - st + 1);
      const LAS unsigned char* own = lds + (32 * tb + r32 + 8) * PU_STRIDE + 8 * hi;
#pragma unroll
      for (int cb = 0; cb < 4; ++cb) { u32x2 dw[4];
#pragma unroll
          for (int g4 = 0; g4 < 4; ++g4) { const u32x2 o2 = *(const LAS u32x2*)(own + (32 * cb + 8 * g4) * 2);
              dw[g4].x = cvtpk(acc[cb][4 * g4] * inv - bflo(o2.x), acc[cb][4 * g4 + 1] * inv - bfhi(o2.x)); dw[g4].y = cvtpk(acc[cb][4 * g4 + 2] * inv - bflo(o2.y), acc[cb][4 * g4 + 3] * inv - bfhi(o2.y)); }
          dfr[2 * cb] = __builtin_bit_cast(bf16x8, (u32x4){dw[0].x, dw[0].y, dw[1].x, dw[1].y}); dfr[2 * cb + 1] = __builtin_bit_cast(bf16x8, (u32x4){dw[2].x, dw[2].y, dw[3].x, dw[3].y}); } }
    f32x16 out[2]; out[0] = f32x16{}; out[1] = f32x16{};
#pragma unroll
    for (int nbl = 0; nbl < 2; ++nbl) { const LAS unsigned char* wrow = lds + PW_OFF + (32 * (2 * half + nbl) + r32) * 272 + 8 * hi;
#pragma unroll
        for (int kq = 0; kq < 8; ++kq) { const u32x2 a0 = *(const LAS u32x2*)(wrow + 32 * kq), a1 = *(const LAS u32x2*)(wrow + 32 * kq + 16);
            out[nbl] = __builtin_amdgcn_mfma_f32_32x32x16_bf16(__builtin_bit_cast(bf16x8, (u32x4){a0.x, a0.y, a1.x, a1.y}), dfr[kq], out[nbl], 0, 0, 0); } }
    { LAS unsigned char* ot = lds + PO_OFF + (32 * tb + r32) * 272;
#pragma unroll
      for (int nbl = 0; nbl < 2; ++nbl)
#pragma unroll
        for (int rq = 0; rq < 4; ++rq) { const int n0 = 32 * (2 * half + nbl) + 8 * rq + 4 * hi; const f32x4 ps = *(const f32x4*)(pool_scale + gi * 128 + n0);
            u32x2 w; w.x = cvtpk(out[nbl][4 * rq] * ps.x, out[nbl][4 * rq + 1] * ps.y); w.y = cvtpk(out[nbl][4 * rq + 2] * ps.z, out[nbl][4 * rq + 3] * ps.w);
            *(LAS u32x2*)(ot + n0 * 2) = w; } }
    __syncthreads();
#pragma unroll
    for (int k = 0; k < 4; ++k) { const int cidx = tid + 512 * k, row = cidx >> 4, ch = cidx & 15;
        *(u32x4*)(MIX + ((size_t)b * SEQ + t0 + row) * D + 512 + gi * 128 + ch * 8) = *(const LAS u32x4*)(lds + PO_OFF + row * 272 + ch * 16); }
}

constexpr int AK_STRIDE = 144, AV_STRIDE = 320, AK_BYTES = 64 * AK_STRIDE, AKS = 2 * AK_BYTES  , AVS = 64 * AV_STRIDE  , AV_BASE = 3 * AKS;
#define SBAR() __builtin_amdgcn_sched_barrier(0)
typedef float f32x2_t __attribute__((ext_vector_type(2))); typedef __bf16 bf16x2_t __attribute__((ext_vector_type(2)));
__device__ __forceinline__ unsigned cvtpk_s(float lo, float hi) { f32x2_t v = {lo, hi}; bf16x2_t bb = __builtin_convertvector(v, bf16x2_t); return __builtin_bit_cast(unsigned, bb); }
__device__ __forceinline__ s16x4 vtr(const LAS unsigned char* p) { return __builtin_bit_cast(s16x4, __builtin_amdgcn_ds_read_tr16_b64_v4i16((LAS s16x4*)p)); }
__device__ __forceinline__ bf16x8 vfrag(const LAS unsigned char* p) { const s16x4 vl = vtr(p), vh = vtr(p + 8 * AV_STRIDE); return (bf16x8){vl[0], vl[1], vl[2], vl[3], vh[0], vh[1], vh[2], vh[3]}; }
__device__ __forceinline__ void glds16(const void* gsrc, unsigned lds_dst) { unsigned keep;
    asm volatile("s_mov_b32 %0, m0\n\ts_mov_b32 m0, %2\n\ts_nop 0\n\tglobal_load_lds_dwordx4 %1, off\n\ts_mov_b32 m0, %0" : "=&s"(keep) : "v"(gsrc), "s"(lds_dst) : "memory"); }
__device__ __forceinline__ float max3f(float a, float b, float c) { float r; asm("v_max3_f32 %0, %1, %2, %3" : "=v"(r) : "v"(a), "v"(b), "v"(c)); return r; }
#define WAIT_BAR0() asm volatile("s_waitcnt vmcnt(0) lgkmcnt(0)\n\ts_barrier" ::: "memory")
#define WAIT_BAR5() asm volatile("s_waitcnt vmcnt(5) lgkmcnt(0)\n\ts_barrier" ::: "memory")
template <int MODE> __device__ __forceinline__ void attn_unit(LAS unsigned char* lds, int b, int h, int qb, const bf16* HQ, const bf16* KP, const bf16* VP, bf16* MIX, const float* g_sub, float lam, int tid, int wave, int lane) {
    const int r32 = lane & 31, hi = lane >> 5, map = wave >> 2, qw = wave & 3;
    const size_t qrow = (size_t)b * SEQ + qb * 128 + qw * 32 + r32;
    bf16x8 qf[4];
#pragma unroll
    for (int d0 = 0; d0 < 4; ++d0) qf[d0] = *(const bf16x8*)(HQ + qrow * 512 + h * 128 + map * 64 + d0 * 16 + hi * 8);
    unsigned soff[5], ldst[5]; bool isv[5], valid[5];
#pragma unroll
    for (int i = 0; i < 5; ++i) { const int bid = wave + 8 * i; valid[i] = bid < 38; isv[i] = bid >= 18;
        if (bid < 18) { const int km = bid / 9, j = bid % 9, p = 64 * j + lane, row = p / 9; int ch = p % 9; if (ch == 8) ch = 0;
            soff[i] = (unsigned)(row * 128 + km * 64 + ch * 8) * 2u; ldst[i] = km * AK_BYTES + j * 1024; }
        else { const int j = bid - 18, p = 64 * j + lane, row = p / 20; int ch = p % 20; if (ch >= 16) ch = 0;
            soff[i] = (unsigned)(row * 128 + ch * 8) * 2u; ldst[i] = j * 1024; } }
    if (!valid[4]) { soff[4] = soff[0]; ldst[4] = ldst[0]; isv[4] = isv[0]; valid[4] = true; }
    const unsigned lds0 = (unsigned)(uintptr_t)lds;
    const char* kbase = (const char*)(KP + (size_t)(b * 4 + h) * 4352 * 128); const char* vbase = (const char*)(VP + (size_t)(b * 4 + h) * 4352 * 128);
#define DMA_I(i, tk, sk, tv, sv, dok, dov) do { if (!(MODE & 2) && (isv[i] ? (dov) : (dok))) { const int tt_ = isv[i] ? (tv) : (tk); \
        glds16((isv[i] ? vbase : kbase) + (size_t)tt_ * 16384 + soff[i], (unsigned)__builtin_amdgcn_readfirstlane(lds0 + (isv[i] ? AV_BASE + (sv) * AVS : (sk) * AKS) + ldst[i])); } } while (0)
#define DMA_KV(tk, sk, tv, sv, dok, dov) do { DMA_I(0, tk, sk, tv, sv, dok, dov); DMA_I(1, tk, sk, tv, sv, dok, dov); DMA_I(2, tk, sk, tv, sv, dok, dov); DMA_I(3, tk, sk, tv, sv, dok, dov); DMA_I(4, tk, sk, tv, sv, dok, dov); } while (0)
    constexpr int NT = (SEQ + CTX) / 64;
    DMA_KV(0, 0, 0, 0, true, false);
    DMA_KV(1, 1, 0, 0, true, true);
    WAIT_BAR5();
    f32x16 o[4]; o[0] = f32x16{}; o[1] = f32x16{}; o[2] = f32x16{}; o[3] = f32x16{};
    const f32x16 zero16 = f32x16{};
    float mrun = -INFINITY, lrun = 0.f;
    const unsigned koff = map * AK_BYTES + r32 * AK_STRIDE + hi * 16;
    const unsigned voff = AV_BASE + (4 * hi + ((lane & 15) >> 2)) * AV_STRIDE + (16 * ((lane >> 4) & 1) + 4 * (lane & 3)) * 2;
    u32x4 pw[4];
    f32x16 X0, X1;
#define KFR(i) (*(const LAS bf16x8*)(kb_ + (1 - ((i) >> 2)) * 32 * AK_STRIDE + ((i) & 3) * 32))
#define VFR(i) vfrag(vb_ + ((i) >> 2) * 16 * AV_STRIDE + ((i) & 3) * 64)
#define GAPA(i, HASP) do { if ((i) + 3 < 8) kr[((i) + 3) & 3] = KFR((i) + 3); \
        if ((i) < 4) { X1 = __builtin_amdgcn_mfma_f32_32x32x16_bf16(kr[(i) & 3], qf[(i) & 3], ((i) & 3) ? X1 : zero16, 0, 0, 0); \
            if (HASP) { sacc += (X0[(4 * (i)) & 15] + X0[(4 * (i) + 1) & 15]) + (X0[(4 * (i) + 2) & 15] + X0[(4 * (i) + 3) & 15]); \
                pw[((i) >> 1) & 1][((i) & 1) * 2] = cvtpk_s(X0[(4 * (i)) & 15], X0[(4 * (i) + 1) & 15]); pw[((i) >> 1) & 1][((i) & 1) * 2 + 1] = cvtpk_s(X0[(4 * (i) + 2) & 15], X0[(4 * (i) + 3) & 15]); asm volatile("" : "+v"(sacc)); } } \
        else X0 = __builtin_amdgcn_mfma_f32_32x32x16_bf16(kr[(i) & 3], qf[(i) & 3], ((i) & 3) ? X0 : zero16, 0, 0, 0); \
        SBAR(); } while (0)
#define EXC_(v) do { if (MODE & 1) break; if ((v) < 16) X0[(v) & 15] = __builtin_amdgcn_exp2f(X0[(v) & 15] - mrun); else X1[(v) & 15] = __builtin_amdgcn_exp2f(X1[(v) & 15] - mrun); } while (0)
#define GAPB(i, HASP) do { if ((HASP) && !(MODE & 4)) { if ((i) + 3 < 16) vr[((i) + 3) & 3] = VFR((i) + 3); \
            o[(i) & 3] = __builtin_amdgcn_mfma_f32_32x32x16_bf16(vr[(i) & 3], __builtin_bit_cast(bf16x8, pw[(i) >> 2]), o[(i) & 3], 0, 0, 0); } \
        EXC_(2 * (i)); EXC_(2 * (i) + 1); if ((i) < 8) asm volatile("" : "+v"(X0)); else asm volatile("" : "+v"(X1)); SBAR(); } while (0)
#define STEP(t, s0, HASP, DOK, DOV, WAITB) do { \
        const int s1_ = ((s0) == 2) ? 0 : (s0) + 1, s2_ = ((s0) == 0) ? 2 : (s0) - 1;     \
        const LAS unsigned char* kb_ = lds + (s0) * AKS + koff; const LAS unsigned char* vb_ = lds + s2_ * AVS + voff; \
        DMA_KV((t) + 2, s2_, (t) + 1, s1_, DOK, DOV); \
        bf16x8 kr[4]; kr[0] = KFR(0); kr[1] = KFR(1); kr[2] = KFR(2); float sacc = 0.f; SBAR(); \
        GAPA(0, HASP); GAPA(1, HASP); GAPA(2, HASP); GAPA(3, HASP); GAPA(4, HASP); GAPA(5, HASP); GAPA(6, HASP); GAPA(7, HASP); \
        lrun += sacc; \
        bf16x8 vr[4]; if ((HASP) && !(MODE & 4)) { vr[0] = VFR(0); vr[1] = VFR(1); vr[2] = VFR(2); } \
        float mx = fmaxf(X0[0], X1[0]); \
        if (!(MODE & 1)) { _Pragma("unroll") for (int r_ = 1; r_ < 16; ++r_) mx = max3f(mx, X0[r_], X1[r_]); } \
        { auto rr_ = __builtin_amdgcn_permlane32_swap(__float_as_uint(mx), __float_as_uint(mx), false, false); mx = max3f(mx, __uint_as_float(rr_[0]), __uint_as_float(rr_[1])); } \
        const bool resc = __any(mx > mrun); const float mn = max3f(mrun, mrun, mx), fsc = __builtin_amdgcn_exp2f(mrun - mn); lrun *= fsc; mrun = mn;     \
        SBAR(); \
        GAPB(0, HASP); GAPB(1, HASP); GAPB(2, HASP); GAPB(3, HASP); GAPB(4, HASP); GAPB(5, HASP); GAPB(6, HASP); GAPB(7, HASP); \
        GAPB(8, HASP); GAPB(9, HASP); GAPB(10, HASP); GAPB(11, HASP); GAPB(12, HASP); GAPB(13, HASP); GAPB(14, HASP); GAPB(15, HASP); \
        if (resc) { _Pragma("unroll") for (int db_ = 0; db_ < 4; ++db_) o[db_] = o[db_] * fsc; } \
        { float st_ = 0.f; _Pragma("unroll") for (int r_ = 0; r_ < 16; ++r_) st_ += X1[r_]; lrun += st_; \
          pw[2] = (u32x4){cvtpk_s(X1[0], X1[1]), cvtpk_s(X1[2], X1[3]), cvtpk_s(X1[4], X1[5]), cvtpk_s(X1[6], X1[7])}; \
          pw[3] = (u32x4){cvtpk_s(X1[8], X1[9]), cvtpk_s(X1[10], X1[11]), cvtpk_s(X1[12], X1[13]), cvtpk_s(X1[14], X1[15])}; } \
        WAITB(); } while (0)
    STEP(0, 0, false, true, true, WAIT_BAR5);
    { int s0 = 1;
      for (int t = 1; t < NT - 2; ++t) { STEP(t, s0, true, true, true, WAIT_BAR5); s0 = (s0 == 2) ? 0 : s0 + 1; } }
    STEP(NT - 2, (NT - 2) % 3, true, false, true, WAIT_BAR0);
    STEP(NT - 1, (NT - 1) % 3, true, false, false, WAIT_BAR0);
    { float sacc = 0.f;
#pragma unroll
      for (int r = 0; r < 16; ++r) sacc += X0[r];
      lrun += sacc;
      pw[0] = (u32x4){cvtpk_s(X0[0], X0[1]), cvtpk_s(X0[2], X0[3]), cvtpk_s(X0[4], X0[5]), cvtpk_s(X0[6], X0[7])};
      pw[1] = (u32x4){cvtpk_s(X0[8], X0[9]), cvtpk_s(X0[10], X0[11]), cvtpk_s(X0[12], X0[13]), cvtpk_s(X0[14], X0[15])};
      const LAS unsigned char* vb_ = lds + ((NT - 1) % 3) * AVS + voff;
#pragma unroll
      for (int i = 0; i < 16; ++i) o[i & 3] = __builtin_amdgcn_mfma_f32_32x32x16_bf16(VFR(i), __builtin_bit_cast(bf16x8, pw[i >> 2]), o[i & 3], 0, 0, 0);
    }
    __syncthreads();
#undef DMA_I
#undef DMA_KV
#undef KFR
#undef VFR
#undef GAPA
#undef EXC_
#undef GAPB
#undef STEP
    lrun += __shfl_xor(lrun, 32);
    const float rl = 1.0f / lrun;
    LAS float* ex = (LAS float*)lds + qw * 4096;
    if (map == 1) {
#pragma unroll
        for (int db = 0; db < 4; ++db)
#pragma unroll
            for (int r = 0; r < 16; ++r) ex[(db * 16 + r) * 64 + lane] = o[db][r] * rl;
    }
    __syncthreads();
    if (map == 0) {
        float ss = 0.f;
#pragma unroll
        for (int db = 0; db < 4; ++db)
#pragma unroll
            for (int r = 0; r < 16; ++r) { const float v = o[db][r] * rl - lam * ex[(db * 16 + r) * 64 + lane]; o[db][r] = v; ss += v * v; }
        ss += __shfl_xor(ss, 32);
        const float rstd = (1.0f - LAM_INIT) / sqrtf(ss * (1.0f / 128.0f) + EPS);
        bf16* op = MIX + qrow * D + h * 128;
#pragma unroll
        for (int db = 0; db < 4; ++db)
#pragma unroll
            for (int rq = 0; rq < 4; ++rq) { const int d0 = 32 * db + 8 * rq + 4 * hi; const f32x4 gsv = *(const LAS f32x4*)(lds + 131072 + 2048 + d0 * 4);
                u32x2 w; w.x = cvtpk(o[db][4 * rq] * rstd * gsv.x, o[db][4 * rq + 1] * rstd * gsv.y); w.y = cvtpk(o[db][4 * rq + 2] * rstd * gsv.z, o[db][4 * rq + 3] * rstd * gsv.w);
                *(u32x2*)(op + d0) = w; }
    }
    __syncthreads();
}
#undef SBAR

#define XB_TMO      128
#define XB_XCNT(j)  (256  + 64 * (j))
#define XB_XSUB(j)  (1280 + 64 * (j))
#define XB_XGEN(j)  (2304 + 64 * (j))
#define XB_TOP      3328
#define XB_TOPGEN   3392
#define XCD_BAR_WORDS 3456
#define XB_SPIN_CAP (1u << 18)

__device__ __forceinline__ unsigned xb_ld(unsigned* p)              { return __hip_atomic_load(p, __ATOMIC_RELAXED, __HIP_MEMORY_SCOPE_AGENT); }
__device__ __forceinline__ unsigned xb_add(unsigned* p, unsigned v) { return __hip_atomic_fetch_add(p, v, __ATOMIC_RELAXED, __HIP_MEMORY_SCOPE_AGENT); }
__device__ __forceinline__ unsigned xb_xcc_id() { return (unsigned)__builtin_amdgcn_s_getreg((3 << 11) | 20) & 0xFu; }
#define XB_SPIN(cond, bar) do { unsigned _sp = 0; while (cond) { __builtin_amdgcn_s_sleep(1); \
    if ((++_sp & 255u) == 0u) { if (xb_ld(&(bar)[XB_TMO])) break; if (_sp > XB_SPIN_CAP) { atomicAdd(&(bar)[XB_TMO], 1u); break; } } } } while (0)

struct XcdBarrier {
    unsigned* bar; unsigned x;
    volatile LAS unsigned* st;
};

__device__ __forceinline__ XcdBarrier xcd_barrier_post(unsigned* bar, volatile LAS unsigned* st) {
    XcdBarrier b; b.bar = bar; b.x = xb_xcc_id(); b.st = st;
    if (threadIdx.x == 0) (void)xb_add(&bar[XB_XCNT(b.x)], 1u);
    return b;
}
__device__ __forceinline__ void xcd_barrier_complete(unsigned* bar, unsigned x, unsigned& nloc, unsigned& nx) {
    const unsigned G = gridDim.x * gridDim.y * gridDim.z;
    unsigned sum, cnt, mine, sp = 0u;
    for (;;) {
        sum = 0u; cnt = 0u; mine = 0u;
#pragma unroll
        for (unsigned j = 0; j < 16; ++j) { const unsigned c = xb_ld(&bar[XB_XCNT(j)]); sum += c; cnt += (c > 0u) ? 1u : 0u; mine = (j == x) ? c : mine; }
        if (sum == G) break;
        __builtin_amdgcn_s_sleep(1);
        if ((++sp & 255u) == 0u) { if (xb_ld(&bar[XB_TMO])) break; if (sp > XB_SPIN_CAP) { atomicAdd(&bar[XB_TMO], 1u); break; } }
    }
    nloc = mine > 0u ? mine : 1u; nx = cnt > 0u ? cnt : 1u;
}

__device__ __forceinline__ void xcd_barrier(const XcdBarrier& b) {
    asm volatile("s_waitcnt vmcnt(0)" ::: "memory");
    __syncthreads();
    if (threadIdx.x == 0) {
        unsigned* bar = b.bar;
        __builtin_amdgcn_s_waitcnt(0);
        unsigned nloc = b.st[0], nx = b.st[1];
        if (nloc == 0u) { xcd_barrier_complete(bar, b.x, nloc, nx); b.st[0] = nloc; b.st[1] = nx; }
        const unsigned old = xb_add(&bar[XB_XSUB(b.x)], 1u);
        const unsigned gen = old / nloc;
        if (old + 1u == (gen + 1u) * nloc) {
            __builtin_amdgcn_fence(__ATOMIC_RELEASE, "agent");
            asm volatile("s_waitcnt vmcnt(0)" ::: "memory");
            const unsigned og = xb_add(&bar[XB_TOP], 1u);
            const unsigned tg = og / nx;
            if (og + 1u == (tg + 1u) * nx) xb_add(&bar[XB_TOPGEN], 1u);
            else XB_SPIN(xb_ld(&bar[XB_TOPGEN]) == tg, bar);
            __builtin_amdgcn_fence(__ATOMIC_ACQUIRE, "agent");
            xb_add(&bar[XB_XGEN(b.x)], 1u);
            asm volatile("s_waitcnt vmcnt(0)" ::: "memory");
        } else {
            XB_SPIN(xb_ld(&bar[XB_XGEN(b.x)]) == gen, bar);
            __builtin_amdgcn_fence(__ATOMIC_ACQUIRE, "agent");
            asm volatile("s_waitcnt vmcnt(0)" ::: "memory");
        }
    }
    __syncthreads();
}

struct Args { const float* in[23]; float* out; unsigned char* ws; int ph_lo, ph_hi; };
__global__ void __launch_bounds__(NWAVES * 64, 2) mk_fwd(Args a) {
    extern __shared__ __attribute__((aligned(16))) unsigned char lds_raw[];
    LAS unsigned char* lds = (LAS unsigned char*)lds_raw;
    const int tid = threadIdx.x, lane = tid & 63, wave = __builtin_amdgcn_readfirstlane(tid >> 6), G = gridDim.x, bx = blockIdx.x;
    unsigned char* ws = a.ws;
    const float *x = a.in[0], *c = a.in[1], *ctx = a.in[2], *c_ctx = a.in[3], *w_mod = a.in[4], *b_mod = a.in[5], *g_ffn1 = a.in[6], *ffn1_w_in = a.in[7], *ffn1_w_out = a.in[8],
                *g_mix = a.in[9], *w_in = a.in[10], *lq1 = a.in[11], *lk1 = a.in[12], *lq2 = a.in[13], *lk2 = a.in[14], *g_sub = a.in[15], *w_pool = a.in[16], *pool_scale = a.in[17],
                *w_out = a.in[18], *g_ffn2 = a.in[19], *ffn2_w_in = a.in[20], *ffn2_w_out = a.in[21], *g_final = a.in[22];
    float* mod = (float*)(ws + WS_MOD);
    bf16 *W1A = (bf16*)(ws + WS_W1A), *W2A = (bf16*)(ws + WS_W2A), *W1B = (bf16*)(ws + WS_W1B), *W2B = (bf16*)(ws + WS_W2B), *WINt = (bf16*)(ws + WS_WIN), *WOUTt = (bf16*)(ws + WS_WOUT), *WPt = (bf16*)(ws + WS_WP);
    bf16 *HN = (bf16*)(ws + WS_HN), *MIX = (bf16*)(ws + WS_HN), *ACT = (bf16*)(ws + WS_BIG), *HX = (bf16*)(ws + WS_BIG)  , *KP = (bf16*)(ws + WS_BIG + 68 * MiB), *VP = (bf16*)(ws + WS_BIG + 102 * MiB);
    float* X1 = (float*)(ws + WS_X1);
    float* xpart = (float*)(ws + 44 * MiB); unsigned* xcnt = (unsigned*)(ws + 700 * 1024);
    constexpr int I1 = (D / 64) * (2 * DFF / 32), I2 = (DFF / 64) * (D / 32), I3 = (D / 64) * (INW / 32), I4 = (D / 64) * (D / 32), I5 = 4 * 2 * 4;
#define CONV_RANGE(ilo, ihi, first_wg) do { const int fw_ = ((first_wg) < G) ? (first_wg) : 0; if (bx >= fw_) { LAS float* scr = (LAS float*)(lds + wave * 16384); \
        for (int it = (ilo) + (bx - fw_) * NWAVES + wave; it < (ihi); it += (G - fw_) * NWAVES) { int r = it; \
            if (r < I1) { transpose_mat_item(ffn1_w_in, D, 2 * DFF, W1A, true, r, scr, lane); continue; } r -= I1; \
            if (r < I1) { transpose_mat_item(ffn2_w_in, D, 2 * DFF, W1B, true, r, scr, lane); continue; } r -= I1; \
            if (r < I2) { transpose_mat_item(ffn1_w_out, DFF, D, W2A, false, r, scr, lane); continue; } r -= I2; \
            if (r < I2) { transpose_mat_item(ffn2_w_out, DFF, D, W2B, false, r, scr, lane); continue; } r -= I2; \
            if (r < I3) { transpose_mat_item(w_in, D, INW, WINt, false, r, scr, lane); continue; } r -= I3; \
            if (r < I4) { transpose_mat_item(w_out, D, D, WOUTt, false, r, scr, lane); continue; } r -= I4; \
            { const int gi = r >> 3; transpose_mat_item(w_pool + (size_t)gi * 128 * 128, 128, 128, WPt + (size_t)gi * 128 * 128, false, r & 7, scr, lane); } } } } while (0)
    const int lo = a.ph_lo, hi = a.ph_hi;
#define IN(k) (lo <= (k) && (k) < hi)
#define SEAM(k) do { if (IN(k) && IN((k) + 1)) xcd_barrier(bar); } while (0)

    if (tid < 4) ((volatile LAS unsigned*)(lds + 131072 + 64))[tid] = 0u;
    __syncthreads();
    if (IN(0)) {
        if (bx == 0) for (int i = tid; i < XCD_BAR_WORDS; i += 512) ((unsigned*)(ws + WS_BAR))[i] = 0u;
        for (int i = bx * 512 + tid; i < 3 * 128 * 64; i += G * 512) xcnt[i] = 0u;
        for (int u = bx; u < 144; u += G) adaln_unit(lds, u, c, c_ctx, w_mod, b_mod, mod, tid);
        CONV_RANGE(0, I1, 0); CONV_RANGE(2 * I1, 2 * I1 + I2, 0);
    }
    XcdBarrier bar; bar.bar = (unsigned*)(ws + WS_BAR); bar.x = 0; bar.st = nullptr;
    if (IN(0) && IN(1)) {
        cg::this_grid().sync();
        bar.bar = (unsigned*)(ws + WS_BAR); bar.x = xb_xcc_id(); bar.st = (volatile LAS unsigned*)(lds + 131072 + 64);
        if (tid == 0) bar.st[2] = xb_add(&bar.bar[XB_XCNT(bar.x)], 1u);
    }
    if (IN(1)) norm_pass(x, ctx, NTOK, g_ffn1, mod, 0, 1, HN, nullptr, wave, lane);
    SEAM(1);
    if (IN(2)) { pg8::Gemm g{HN, W1A, NTOK, 2 * DFF, D}; pg8::StaticOrder S; S.init(NTOK, 2 * DFF, G, bx, D); pg8::EpiSwiglu E{ACT, DFF};
        pg8::gemm_phase<pg8::EpiSwiglu, pg8::StaticOrder, true, true>(lds, g, S, E);
        CONV_RANGE(2 * I1 + 2 * I2, 2 * I1 + 2 * I2 + I3 + I4 + I5, ((NTOK / 256) * (2 * DFF / 256)) % G); }
    SEAM(2);
    if (IN(3)) { pg8::Gemm g{ACT, W2A, NTOK, D, DFF};
        { pg8::StaticOrder S; S.init(NLAT, D, G, bx, DFF);
          pg8::EpiResidRms<1, false> E{x, X1, mod + 2 * D, g_mix, mod + 4 * D, mod + 3 * D, HN, xpart, xcnt, (PG8_LAS float*)(lds + 131072 + 1024), nullptr};
          pg8::gemm_phase<pg8::EpiResidRms<1, false>, pg8::StaticOrder, true, true>(lds, g, S, E); }
        { pg8::SplitOnlyOrder S; S.init(NLAT, G, bx);
          pg8::EpiSplitRaw E{a.out};
          pg8::gemm_phase<pg8::EpiSplitRaw, pg8::SplitOnlyOrder, true, true>(lds, g, S, E); }
        CONV_RANGE(2 * I1 + I2, 2 * I1 + 2 * I2, 128); }
    SEAM(3);
    if (IN(4)) norm_pass(X1, ctx, NTOK, g_mix, mod, 3, 4, HN, nullptr, wave, lane, a.out, mod + (size_t)8 * NMOD + 2 * D, NLAT);
    SEAM(4);
    if (IN(5)) { pg8::Gemm g{HN, WINt, NTOK, INW, D}; pg8::StaticOrder S; S.init(NTOK, INW, G, bx, D); pg8::EpiInproj E{HX, KP, VP, QSCALE};
        pg8::gemm_phase<pg8::EpiInproj, pg8::StaticOrder, true, true>(lds, g, S, E);
        CONV_RANGE(I1, 2 * I1, ((NTOK / 256) * (INW / 256)) % G); }
    SEAM(5);
    if (IN(6)) {
        { u32x4 pv[5], pw_[4]; int u = bx;
          if (u < 1024) pool_load(u >> 2, (u + (u >> 8)) & 3, HX, WPt, pv, pw_, tid);
          for (; u < 1024; u += G) { pool_stage(lds, pv, pw_, tid); __syncthreads();
              const int un = u + G; if (un < 1024) pool_load(un >> 2, (un + (un >> 8)) & 3, HX, WPt, pv, pw_, tid);
              pool_compute(lds, u >> 2, (u + (u >> 8)) & 3, pool_scale, MIX, tid, wave, lane); } }
        __syncthreads();
        float d1 = 0.f, d2 = 0.f;
        for (int i = 0; i < 64; ++i) { d1 += lq1[i] * lk1[i]; d2 += lq2[i] * lk2[i]; }
        if (tid < 128) ((LAS float*)(lds + 131072 + 2048))[tid] = g_sub[tid];
        const float lam = __expf(d1) - __expf(d2) + LAM_INIT;
        int xcd = bx & 7, j = bx >> 3;
        if (IN(0)) {
            bool okc = (G == 256);
            for (int q = 0; q < 8; ++q) okc = okc && (xb_ld(&bar.bar[XB_XCNT(q)]) == 32u);
            if (okc && bar.x < 8u) { xcd = (int)bar.x; j = (int)((volatile LAS unsigned*)(lds + 131072 + 64))[2]; }
        }
        for (int u = j; u < 128; u += (G >> 3)) { const int bh = 4 * xcd + (u >> 5), qb = u & 31; attn_unit<0>(lds, bh >> 2, bh & 3, qb, HX, KP, VP, MIX, g_sub, lam, tid, wave, lane); }
    }
    SEAM(6);
    if (IN(7)) { pg8::Gemm g{MIX, WOUTt, NLAT, D, D}; pg8::StaticOrder S; S.init(NLAT, D, G, bx, D);
        pg8::EpiResidRms<2, false> E{X1, X1, mod + 5 * D, g_ffn2, mod + 7 * D, mod + 6 * D, (bf16*)a.out, xpart, xcnt + 1 * 128 * 64, (PG8_LAS float*)(lds + 131072 + 1024), nullptr};
        pg8::gemm_phase<pg8::EpiResidRms<2, false>, pg8::StaticOrder, true, true>(lds, g, S, E); }
    SEAM(7);
    if (IN(9)) { pg8::Gemm g{(const bf16*)a.out, W1B, NLAT, 2 * DFF, D}; pg8::StaticOrder S; S.init(NLAT, 2 * DFF, G, bx, D); pg8::EpiSwiglu E{ACT, DFF};
        pg8::gemm_phase<pg8::EpiSwiglu, pg8::StaticOrder, true, true>(lds, g, S, E); }
    SEAM(9);
    if (IN(10)) { pg8::Gemm g{ACT, W2B, NLAT, D, DFF}; pg8::StaticOrder S; S.init(NLAT, D, G, bx, DFF);
        pg8::EpiResidRms<1, true> E{X1, a.out, mod + 8 * D, g_final, nullptr, nullptr, nullptr, xpart, xcnt + 2 * 128 * 64, (PG8_LAS float*)(lds + 131072 + 1024), nullptr};
        pg8::gemm_phase<pg8::EpiResidRms<1, true>, pg8::StaticOrder, true, true>(lds, g, S, E); }
#undef IN
#undef CONV_RANGE
#undef SEAM
}

extern "C" void kernel_launch(void* const* d_in, const int* in_sizes, int n_in, void* d_out, int out_size, void* d_ws, size_t ws_size, hipStream_t stream) {
    static int grid = 0;
    if (grid == 0) {
        if (n_in != 23 || in_sizes[0] != NLAT * D || out_size != NLAT * D || ws_size < WS_END) { fprintf(stderr, "kernel_launch: unexpected shapes (n_in %d, in0 %d, out %d, ws %zu)\n", n_in, n_in > 0 ? in_sizes[0] : -1, out_size, ws_size); grid = -1; return; }
        int dev = 0, cus = 0, per_cu = 0;
        if (hipGetDevice(&dev) != hipSuccess || hipDeviceGetAttribute(&cus, hipDeviceAttributeMultiprocessorCount, dev) != hipSuccess) { grid = -1; return; }
        if (hipFuncSetAttribute((const void*)mk_fwd, hipFuncAttributeMaxDynamicSharedMemorySize, LDS_BYTES) != hipSuccess) { fprintf(stderr, "kernel_launch: hipFuncSetAttribute failed\n"); grid = -1; return; }
        if (hipOccupancyMaxActiveBlocksPerMultiprocessor(&per_cu, (const void*)mk_fwd, NWAVES * 64, LDS_BYTES) != hipSuccess || per_cu < 1) { fprintf(stderr, "kernel_launch: occupancy query says %d blocks/CU\n", per_cu); grid = -1; (void)hipGetLastError(); return; }
        grid = cus;
    }
    if (grid < 0) return;
    Args a{};
    for (int i = 0; i < 23; ++i) a.in[i] = (const float*)d_in[i];
    a.out = (float*)d_out; a.ws = (unsigned char*)d_ws;
#if MK_N_LAUNCHES == 1
    a.ph_lo = 0; a.ph_hi = NPHASE;
    void* args[] = {&a};
    hipError_t e = hipLaunchCooperativeKernel((const void*)mk_fwd, dim3(grid), dim3(NWAVES * 64), args, LDS_BYTES, stream);
    if (e != hipSuccess) fprintf(stderr, "kernel_launch: cooperative launch failed: %s (grid %d)\n", hipGetErrorString(e), grid);
#else
    for (int p = 0; p < NPHASE; ++p) { a.ph_lo = p; a.ph_hi = p + 1; hipLaunchKernelGGL(mk_fwd, dim3(grid), dim3(NWAVES * 64), LDS_BYTES, stream, a); }
#endif
}
```

```cpp
#include <hip/hip_runtime.h>
#include <cstdio>
#include <cstdint>
#include <cmath>
namespace pg8 {
#define PG8_LAS __attribute__((address_space(3)))
typedef unsigned short bf16_t;
typedef short bf16x8 __attribute__((ext_vector_type(8)));
typedef float f32x4 __attribute__((ext_vector_type(4)));
typedef unsigned u32x4 __attribute__((ext_vector_type(4)));
constexpr int BM = 256, BK = 64, HALF = 128, HTB = HALF * BK * 2  , STAGE_BYTES = 8 * HTB, NXCD = 8, WGM = 8;

__host__ __device__ __forceinline__ int lds_byte(int r, int c) { const int st = (r >> 4) * 2 + (c >> 5), rr = r & 15, cc = c & 31, ob = rr * 64 + cc * 2; return st * 1024 + (ob ^ (((ob >> 9) & 1) << 5)); }
__host__ __device__ __forceinline__ void stage_rc(int b, int& R, int& C) { const int st = b / 1024, sb = b % 1024, swz = sb ^ (((sb >> 9) & 1) << 5); R = (st >> 1) * 16 + swz / 64; C = (st & 1) * 32 + (swz % 64) / 2; }
__host__ __device__ __forceinline__ int perm32(int rho) { const int n = rho >> 4, i = rho & 15; return 8 * (i >> 2) + 4 * n + (i & 3); }

struct Unit { int pm, pn, kt0, nk; };
struct Gemm { const bf16_t* A; const bf16_t* Bt; int M, N, K; };

struct StaticOrder {
    int nM, nN, nwg, G, c, nkt;
    __host__ __device__ void init(int M, int N, int G_, int c_, int K_) { nM = M / BM; nN = N / BM; nwg = nM * nN; G = G_; c = c_; nkt = K_ / BK; }
    __host__ __device__ bool next(int i, Unit& u) const {
        const long L = (long)i * G + c; if (L >= nwg) return false;
        int wgid = (int)L; { const int q = nwg / NXCD, r = nwg % NXCD, xcd = wgid % NXCD, off = wgid / NXCD; wgid = (xcd < r ? xcd * (q + 1) : r * (q + 1) + (xcd - r) * q) + off; }
        const int nig = WGM * nN, gid = wgid / nig, fm = gid * WGM, gsz = (nM - fm) < WGM ? (nM - fm) : WGM;
        u.pm = fm + ((wgid % nig) % gsz); u.pn = (wgid % nig) / gsz; u.kt0 = 0; u.nk = nkt; return true;
    }
    __device__ __forceinline__ void a_ready(const Unit&) const {}
    __device__ __forceinline__ void done(const Unit&) const {}
};

struct SplitOrder {
    StaticOrder S; int nfull, G, c;
    __host__ __device__ void init(int Mlat, int N, int G_, int c_, int K_) { S.init(Mlat, N, G_, c_, K_); nfull = S.nwg; G = G_; c = c_; }
    __host__ __device__ bool next(int i, Unit& u) const {
        const long L = (long)i * G + c;
        if (L < nfull) return S.next(i, u);
        const int idx = (int)(L - nfull); if (idx >= 128) return false;
        const int un = idx >> 2, s = idx & 3; u.pm = S.nM + (un >> 2); u.pn = un & 3; u.kt0 = 12 * s; u.nk = (s == 3) ? 8 : 12; return true;
    }
    __device__ __forceinline__ void a_ready(const Unit&) const {}
    __device__ __forceinline__ void done(const Unit&) const {}
};
struct SplitOnlyOrder {
    int nMlat, G, c;
    __host__ __device__ void init(int Mlat, int G_, int c_) { nMlat = Mlat / BM; G = G_; c = c_; }
    __host__ __device__ bool next(int i, Unit& u) const {
        const long L = (long)i * G + c; if (L >= 128) return false;
        const int idx = (int)L, un = idx >> 2, s = idx & 3; u.pm = nMlat + (un >> 2); u.pn = un & 3; u.kt0 = 12 * s; u.nk = (s == 3) ? 8 : 12; return true;
    }
    __device__ __forceinline__ void a_ready(const Unit&) const {}
    __device__ __forceinline__ void done(const Unit&) const {}
};
__device__ __forceinline__ unsigned cvt_pk_bf16(float lo, float hi) { unsigned r; asm volatile("v_cvt_pk_bf16_f32 %0, %1, %2" : "=v"(r) : "v"(lo), "v"(hi)); return r; }
typedef float f32x2 __attribute__((ext_vector_type(2)));
__device__ __forceinline__ f32x2 gelu_pk(f32x2 v) {
    const f32x2 av = __builtin_elementwise_abs(v), d = av * 0.2316418882f + 1.0f;
    f32x2 t; t.x = __builtin_amdgcn_rcpf(d.x); t.y = __builtin_amdgcn_rcpf(d.y);
    f32x2 q = t * 0.5307027145f + (-0.7265760135f); q = q * t + 0.7107068705f; q = q * t + (-0.142248368f); q = q * t + 0.127414796f; q = q * t;
    const f32x2 s = (v * v) * (-0.72134752044f);
    f32x2 e; e.x = __builtin_amdgcn_exp2f(s.x); e.y = __builtin_amdgcn_exp2f(s.y);
    const f32x2 m = v * (q * e), r = v - m;
    f32x2 o; o.x = v.x < 0.f ? m.x : r.x; o.y = v.y < 0.f ? m.y : r.y; return o;
}

typedef unsigned u32x2 __attribute__((ext_vector_type(2)));
__device__ __forceinline__ float silu_f(float g) { return g * __builtin_amdgcn_rcpf(1.0f + __builtin_amdgcn_exp2f(-1.4426950408889634f * g)); }
struct EpiSwiglu {
    static constexpr bool PERM = true, AFTER_DRAIN = false;
    bf16_t* O; int ldo;
    __device__ __forceinline__ void operator()(const f32x4 (&acc)[2][2][4][2], const Unit& u, int wr, int wc, int fr, int fq) const {
        const int row0 = u.pm * BM + wr * 64 + fr, col0 = u.pn * HALF + wc * 32 + 8 * fq;
#pragma unroll
        for (int ai = 0; ai < 2; ++ai)
#pragma unroll
            for (int m = 0; m < 4; ++m) {
                bf16_t* p = O + (size_t)(row0 + ai * HALF + m * 16) * ldo + col0;
                const f32x4 g0 = acc[ai][0][m][0], g1 = acc[ai][0][m][1], u0 = acc[ai][1][m][0], u1 = acc[ai][1][m][1];
                u32x4 w;
                w.x = cvt_pk_bf16(silu_f(g0[0]) * u0[0], silu_f(g0[1]) * u0[1]); w.y = cvt_pk_bf16(silu_f(g0[2]) * u0[2], silu_f(g0[3]) * u0[3]);
                w.z = cvt_pk_bf16(silu_f(g1[0]) * u1[0], silu_f(g1[1]) * u1[1]); w.w = cvt_pk_bf16(silu_f(g1[2]) * u1[2], silu_f(g1[3]) * u1[3]);
                *(u32x4*)p = w;
            }
    }
};
struct EpiResid {
    static constexpr bool PERM = false, AFTER_DRAIN = false;
    const float* rlat; const float* rctx; float* out; const float* gate  ; float coef;
    __device__ __forceinline__ void operator()(const f32x4 (&acc)[2][2][4][2], const Unit& u, int wr, int wc, int fr, int fq) const {
        const bool lat = u.pm < 128; const int rix = lat ? (u.pm >> 4) : 8;
        const float* rb = lat ? rlat + (size_t)u.pm * BM * 1024 : rctx + (size_t)(u.pm - 128) * BM * 1024;
        float* ob = out + (size_t)u.pm * BM * 1024;
        const int col0 = u.pn * BM + wc * 32 + 4 * fq;
        f32x4 gv[2][2];
#pragma unroll
        for (int bj = 0; bj < 2; ++bj)
#pragma unroll
            for (int n = 0; n < 2; ++n) gv[bj][n] = *(const f32x4*)(gate + (size_t)rix * 9216 + col0 + bj * HALF + n * 16) * coef;
#pragma unroll
        for (int ai = 0; ai < 2; ++ai)
#pragma unroll
            for (int m = 0; m < 4; ++m) { const size_t off = (size_t)(ai * HALF + wr * 64 + m * 16 + fr) * 1024 + col0;
#pragma unroll
                for (int bj = 0; bj < 2; ++bj)
#pragma unroll
                    for (int n = 0; n < 2; ++n) { const f32x4 r = *(const f32x4*)(rb + off + bj * HALF + n * 16);
                        *(f32x4*)(ob + off + bj * HALF + n * 16) = r + gv[bj][n] * acc[ai][bj][m][n]; }
                if (m & 1) asm volatile("" ::: "memory"); }
    }
};
struct EpiResidS {
    static constexpr bool PERM = false, AFTER_DRAIN = false;
    const float* rlat; float* out; const float* gate; float* part;
    __device__ __forceinline__ void operator()(const f32x4 (&acc)[2][2][4][2], const Unit& u, int wr, int wc, int fr, int fq) const {
        const float* rlat_ = rlat; float* out_ = out; const float* gate_ = gate; float* part_ = part;
        const int col0 = u.pn * BM + wc * 32 + 4 * fq;
        if (u.pm >= 128) {
            float* pb = part_ + (size_t)(u.kt0 / 12) * (2048 * 1024) + (size_t)(u.pm - 128) * BM * 1024;
#pragma unroll
            for (int ai = 0; ai < 2; ++ai)
#pragma unroll
                for (int m = 0; m < 4; ++m) { const size_t off = (size_t)(ai * HALF + wr * 64 + m * 16 + fr) * 1024 + col0;
#pragma unroll
                    for (int bj = 0; bj < 2; ++bj)
#pragma unroll
                        for (int n = 0; n < 2; ++n) *(f32x4*)(pb + off + bj * HALF + n * 16) = acc[ai][bj][m][n]; }
            return;
        }
        const int rix = u.pm >> 4;
        const float* rb = rlat_ + (size_t)u.pm * BM * 1024; float* ob = out_ + (size_t)u.pm * BM * 1024;
        f32x4 gv[2][2];
#pragma unroll
        for (int bj = 0; bj < 2; ++bj)
#pragma unroll
            for (int n = 0; n < 2; ++n) gv[bj][n] = *(const f32x4*)(gate_ + (size_t)rix * 9216 + col0 + bj * HALF + n * 16) * 0.5f;
#pragma unroll
        for (int ai = 0; ai < 2; ++ai)
#pragma unroll
            for (int m = 0; m < 4; ++m) { const size_t off = (size_t)(ai * HALF + wr * 64 + m * 16 + fr) * 1024 + col0;
#pragma unroll
                for (int bj = 0; bj < 2; ++bj)
#pragma unroll
                    for (int n = 0; n < 2; ++n) { const f32x4 r = *(const f32x4*)(rb + off + bj * HALF + n * 16);
                        *(f32x4*)(ob + off + bj * HALF + n * 16) = r + gv[bj][n] * acc[ai][bj][m][n]; }
                if (m & 1) asm volatile("" ::: "memory"); }
    }
};
template <int COEF2, bool FINAL> struct EpiResidRms {
    static constexpr bool PERM = false, AFTER_DRAIN = false;
    const float* resid; float* xout; const float* gate; const float* g; const float* scm; const float* shm; bf16_t* hn; float* part; unsigned* cnt; PG8_LAS float* tab; float* splitpart  ;
    __device__ __forceinline__ void operator()(const f32x4 (&acc_c)[2][2][4][2], const Unit& u, int wr, int wc, int fr_in, int fq_in) const {
        f32x4 (&acc)[2][2][4][2] = const_cast<f32x4 (&)[2][2][4][2]>(acc_c);
        int fr = fr_in, fq = fq_in; asm volatile("" : "+v"(fr), "+v"(fq));
        if (splitpart != nullptr && u.pm >= 128) {
            float* sb = splitpart + (size_t)(u.kt0 / 12) * (2048 * 1024) + (size_t)(u.pm - 128) * BM * 1024; const int c0 = u.pn * BM + wc * 32 + 4 * fq;
#pragma unroll
            for (int ai = 0; ai < 2; ++ai)
#pragma unroll
                for (int m = 0; m < 4; ++m) { const size_t off = (size_t)(ai * HALF + wr * 64 + m * 16 + fr) * 1024 + c0;
#pragma unroll
                    for (int bj = 0; bj < 2; ++bj)
#pragma unroll
                        for (int n = 0; n < 2; ++n) *(f32x4*)(sb + off + bj * HALF + n * 16) = acc[ai][bj][m][n]; }
            return;
        }
        const float* resid_ = resid; float* xout_ = xout; const float* gate_ = gate; const float* g_ = g; const float* scm_ = scm; const float* shm_ = shm; bf16_t* hn_ = hn; float* part_ = part; unsigned* cnt_ = cnt; PG8_LAS float* tab_ = tab;
        const int rix = u.pm >> 4, col0 = u.pn * BM + wc * 32 + 4 * fq, wid = wr * 4 + wc, lane = fq * 16 + fr, tid = wid * 64 + lane;
        const float* rb = resid_ + (size_t)u.pm * BM * 1024; float* pb = part_ + (size_t)u.pm * BM * 16 + u.pn * 4 + wc;
        PG8_LAS float* vec = tab_ + 384; const int cl = wc * 32 + 4 * fq;
        if (tid < 256) { const int c = u.pn * BM + tid; vec[tid] = gate_[(size_t)rix * 9216 + c] * (0.5f * COEF2);
            if (FINAL) vec[256 + tid] = g_[c]; else { vec[256 + tid] = g_[c] * (scm_[(size_t)rix * 9216 + c] + 1.0f); vec[512 + tid] = shm_[(size_t)rix * 9216 + c]; } }
        asm volatile("s_waitcnt vmcnt(0) lgkmcnt(0)" ::: "memory"); __builtin_amdgcn_s_barrier(); asm volatile("" ::: "memory");
        {
#pragma unroll
          for (int ap = 0; ap < 4; ++ap) { const int ai = ap >> 1, m0 = (ap & 1) * 2; f32x4 rr[2][2][2];
              asm volatile("" ::: "memory");
#pragma unroll
              for (int mm = 0; mm < 2; ++mm) { const size_t off = (size_t)(ai * HALF + wr * 64 + (m0 + mm) * 16 + fr) * 1024 + col0;
#pragma unroll
                  for (int bj = 0; bj < 2; ++bj)
#pragma unroll
                      for (int n = 0; n < 2; ++n) rr[mm][bj][n] = __builtin_nontemporal_load((const f32x4*)(rb + off + bj * HALF + n * 16)); }
#pragma unroll
              for (int mm = 0; mm < 2; ++mm) { const int m = m0 + mm, rl = ai * HALF + wr * 64 + m * 16 + fr; float ss = 0.f;
#pragma unroll
                  for (int bj = 0; bj < 2; ++bj)
#pragma unroll
                      for (int n = 0; n < 2; ++n) { const f32x4 gv = *(const PG8_LAS f32x4*)(vec + cl + bj * HALF + n * 16); const f32x4 o = rr[mm][bj][n] + gv * acc[ai][bj][m][n];
                          acc[ai][bj][m][n] = o; ss += (o[0] * o[0] + o[1] * o[1]) + (o[2] * o[2] + o[3] * o[3]); }
                  ss += __shfl_xor(ss, 16); ss += __shfl_xor(ss, 32);
                  if (fq == 0) __hip_atomic_store(pb + (size_t)rl * 16, ss, __ATOMIC_RELAXED, __HIP_MEMORY_SCOPE_AGENT); } } }
        asm volatile("s_waitcnt vmcnt(0)" ::: "memory");
        unsigned* cw = cnt_ + 64 * u.pm;
        if (lane == 0) __hip_atomic_fetch_add(cw, 1u, __ATOMIC_RELAXED, __HIP_MEMORY_SCOPE_AGENT);
        if (wid == 0) { unsigned sp = 0;
            while ((unsigned)__builtin_amdgcn_readfirstlane(__hip_atomic_load(cw, __ATOMIC_RELAXED, __HIP_MEMORY_SCOPE_AGENT)) < 32u) { __builtin_amdgcn_s_sleep(2); if (++sp > (1u << 22)) break; } }
        asm volatile("s_waitcnt vmcnt(0) lgkmcnt(0)" ::: "memory"); __builtin_amdgcn_s_barrier(); asm volatile("" ::: "memory");
        if (tid < 256) { const unsigned long long* pp = (const unsigned long long*)(part_ + ((size_t)u.pm * BM + tid) * 16); float s = 0.f;
#pragma unroll
            for (int q = 0; q < 8; ++q) { const unsigned long long w = __hip_atomic_load(pp + q, __ATOMIC_RELAXED, __HIP_MEMORY_SCOPE_AGENT); s += __uint_as_float((unsigned)w) + __uint_as_float((unsigned)(w >> 32)); }
            tab_[tid] = 1.0f / sqrtf(s * (1.0f / 1024.0f) + 1e-6f); }
        asm volatile("s_waitcnt vmcnt(0) lgkmcnt(0)" ::: "memory"); __builtin_amdgcn_s_barrier(); asm volatile("" ::: "memory");
        { float* ob = xout_ + (size_t)u.pm * BM * 1024; bf16_t* hb = hn_ + (size_t)u.pm * BM * 1024;
#pragma unroll
          for (int ai = 0; ai < 2; ++ai)
#pragma unroll
            for (int m = 0; m < 4; ++m) { const int rl = ai * HALF + wr * 64 + m * 16 + fr; const size_t off = (size_t)rl * 1024 + col0; const float rs = tab_[rl];
#pragma unroll
                for (int bj = 0; bj < 2; ++bj)
#pragma unroll
                    for (int n = 0; n < 2; ++n) { const f32x4 gs = *(const PG8_LAS f32x4*)(vec + 256 + cl + bj * HALF + n * 16); const f32x4 o = acc[ai][bj][m][n];
                        if (FINAL) *(f32x4*)(ob + off + bj * HALF + n * 16) = o * rs * gs;
                        else { const f32x4 sh = *(const PG8_LAS f32x4*)(vec + 512 + cl + bj * HALF + n * 16);
                               __builtin_nontemporal_store(o, (f32x4*)(ob + off + bj * HALF + n * 16));     const f32x4 a = o * rs * gs + sh; u32x2 w; w.x = cvt_pk_bf16(a[0], a[1]); w.y = cvt_pk_bf16(a[2], a[3]); *(u32x2*)(hb + off + bj * HALF + n * 16) = w; } } }
        }
        asm volatile("s_waitcnt lgkmcnt(0)" ::: "memory"); __builtin_amdgcn_s_barrier(); asm volatile("" ::: "memory");
    }
};
struct EpiSplitRaw {
    static constexpr bool PERM = false, AFTER_DRAIN = false;
    float* part;
    __device__ __forceinline__ void operator()(const f32x4 (&acc)[2][2][4][2], const Unit& u, int wr, int wc, int fr, int fq) const {
        float* sb = part + (size_t)(u.kt0 / 12) * (2048 * 1024) + (size_t)(u.pm - 128) * BM * 1024; const int c0 = u.pn * BM + wc * 32 + 4 * fq;
#pragma unroll
        for (int ai = 0; ai < 2; ++ai)
#pragma unroll
            for (int m = 0; m < 4; ++m) { const size_t off = (size_t)(ai * HALF + wr * 64 + m * 16 + fr) * 1024 + c0;
#pragma unroll
                for (int bj = 0; bj < 2; ++bj)
#pragma unroll
                    for (int n = 0; n < 2; ++n) *(f32x4*)(sb + off + bj * HALF + n * 16) = acc[ai][bj][m][n]; }
    }
};
struct EpiInproj {
    static constexpr bool PERM = false, AFTER_DRAIN = false;
    bf16_t* HQ; bf16_t* KP; bf16_t* VP; float qs;
    __device__ __forceinline__ void operator()(const f32x4 (&acc)[2][2][4][2], const Unit& u, int wr, int wc, int fr, int fq) const {
        const int tt = u.pn >> 1; const bool lat = u.pm < 128; const bool rope = (tt < 2) && lat;
        const int row0 = u.pm * BM + wr * 64 + fr, cw = wc * 32 + 4 * fq;
        float fr4[4];
#pragma unroll
        for (int e = 0; e < 4; ++e) fr4[e] = __builtin_amdgcn_exp2f(-(float)(4 * fq + e) * (13.287712379549449f / 16.0f)) * 0.15915494309189535f;
        const float sc = (tt == 0) ? qs : 1.0f;
#pragma unroll
        for (int ai = 0; ai < 2; ++ai)
#pragma unroll
            for (int m = 0; m < 4; ++m) { const int row = row0 + ai * HALF + m * 16;
                bf16_t* p;
                if (tt == 0) p = HQ + (size_t)row * 512 + (u.pn & 1) * 256 + cw;
                else if (tt == 3) p = HQ + (size_t)34816 * 512 + ((size_t)((u.pn & 1) * 2) * 34816 + row) * 128 + cw;
                else { const int b = lat ? (row >> 12) : ((row - 32768) >> 8), kv = lat ? (row & 4095) : 4096 + ((row - 32768) & 255);
                       p = (tt == 1 ? KP : VP) + ((size_t)(b * 4 + (u.pn & 1) * 2) * 4352 + kv) * 128 + cw; }
                const size_t bjs = (tt == 0) ? (size_t)HALF : (tt == 3) ? (size_t)34816 * 128 : (size_t)4352 * 128;
                float cs[4], sn[4];
                if (rope) { const int t = row & 4095; const float pos = (float)((wc & 1) ? (t & 63) : (t >> 6));
#pragma unroll
                    for (int e = 0; e < 4; ++e) { const float rev = __builtin_amdgcn_fractf(pos * fr4[e]); cs[e] = __builtin_amdgcn_cosf(rev) * sc; sn[e] = __builtin_amdgcn_sinf(rev) * sc; } }
                else {
#pragma unroll
                    for (int e = 0; e < 4; ++e) { cs[e] = sc; sn[e] = 0.f; } }
#pragma unroll
                for (int bj = 0; bj < 2; ++bj) { const f32x4 a0 = acc[ai][bj][m][0], a1 = acc[ai][bj][m][1]; float o0[4], o1[4];
#pragma unroll
                    for (int e = 0; e < 4; ++e) { o0[e] = a0[e] * cs[e] - a1[e] * sn[e]; o1[e] = a1[e] * cs[e] + a0[e] * sn[e]; }
                    u32x2 w0, w1; w0.x = cvt_pk_bf16(o0[0], o0[1]); w0.y = cvt_pk_bf16(o0[2], o0[3]); w1.x = cvt_pk_bf16(o1[0], o1[1]); w1.y = cvt_pk_bf16(o1[2], o1[3]);
                    *(u32x2*)(p + bj * bjs) = w0; *(u32x2*)(p + bj * bjs + 16) = w1; }
            }
    }
};
template <class Epi, class Sched, bool ALIGN_EPI = false, bool SP2 = false>
__device__ __forceinline__ void gemm_phase(PG8_LAS unsigned char* lds, const Gemm g, const Sched& S, const Epi& E) {
    int tid_l = threadIdx.x; asm volatile("" : "+v"(tid_l));
    const int tid = tid_l, wid = __builtin_amdgcn_readfirstlane(tid >> 6), lane = tid & 63, wr = wid >> 2, wc = wid & 3, fr = lane & 15, fq = lane >> 4;
    const int K = g.K; int nt = 0;
    unsigned voffA[2], voffB[2];
#pragma unroll
    for (int i = 0; i < 2; ++i) { int R, C; stage_rc(tid * 16 + i * 8192, R, C); const int Rb = Epi::PERM ? ((R & ~31) + perm32(R & 31)) : R;
        voffA[i] = (unsigned)(R * K + C) * 2u; voffB[i] = (unsigned)(Rb * K + C) * 2u; }
    const size_t kstep = (size_t)(BK * 2);
    const size_t hstep = (size_t)HALF * K * 2;
    const size_t tstep = 2 * hstep;
    const unsigned ldsw = (unsigned)wid * 1024u;
    const int aoff = lds_byte(wr * 64 + fr, fq * 8), boff = lds_byte(wc * 32 + fr, fq * 8);
#define PG8_SA(b, h) (((b) * 2 + (h)) * HTB)
#define PG8_SB(b, h) ((4 + (b) * 2 + (h)) * HTB)
#define PG8_STAGE(bufoff, gbase, voff) do { _Pragma("unroll") for (int _i = 0; _i < 2; ++_i) \
        __builtin_amdgcn_global_load_lds((const unsigned*)((const char*)(gbase) + (voff)[_i]), (PG8_LAS unsigned*)(lds + (bufoff) + ldsw + _i * 8192), 16, 0, 0); } while (0)
#define PG8_LDA(dst, b, h) do { _Pragma("unroll") for (int m = 0; m < 4; ++m) _Pragma("unroll") for (int k = 0; k < 2; ++k) dst[m][k] = *(const PG8_LAS bf16x8*)(lds + PG8_SA(b, h) + aoff + m * 2048 + k * 1024); } while (0)
#define PG8_LDB(dst, b, h) do { _Pragma("unroll") for (int n = 0; n < 2; ++n) _Pragma("unroll") for (int k = 0; k < 2; ++k) dst[n][k] = *(const PG8_LAS bf16x8*)(lds + PG8_SB(b, h) + boff + n * 2048 + k * 1024); } while (0)
#define PG8_MMA(ai, bj, At, Bt) do { __builtin_amdgcn_s_setprio(1); _Pragma("unroll") for (int m = 0; m < 4; ++m) _Pragma("unroll") for (int n = 0; n < 2; ++n) _Pragma("unroll") for (int k = 0; k < 2; ++k) \
        acc[ai][bj][m][n] = __builtin_amdgcn_mfma_f32_16x16x32_bf16(Bt[n][k], At[m][k], acc[ai][bj][m][n], 0, 0, 0); __builtin_amdgcn_s_setprio(0); } while (0)
#define PG8_WAIT_V(n) asm volatile("s_waitcnt vmcnt(" #n ")" ::: "memory")
#define PG8_WAIT_L(n) asm volatile("s_waitcnt lgkmcnt(" #n ")" ::: "memory")
#define PG8_BAR __builtin_amdgcn_s_barrier()
#define PG8_SCHED __builtin_amdgcn_sched_barrier(0)
    Unit cur, nxt; int ui = 0;
    if (!S.next(0, cur)) return;
    f32x4 acc[2][2][4][2];
#pragma unroll
    for (int a = 0; a < 2; ++a)
#pragma unroll
        for (int b = 0; b < 2; ++b)
#pragma unroll
            for (int m = 0; m < 4; ++m)
#pragma unroll
                for (int n = 0; n < 2; ++n) acc[a][b][m][n] = (f32x4){0.f, 0.f, 0.f, 0.f};
    bf16x8 At[4][2], B0[2][2], B1[2][2];
    nt = cur.nk;
    const char* cA = (const char*)g.A + (size_t)cur.pm * tstep + (size_t)cur.kt0 * kstep; const char* cB = (const char*)g.Bt + (size_t)cur.pn * tstep + (size_t)cur.kt0 * kstep;
    S.a_ready(cur);
    if constexpr (SP2) {
        PG8_STAGE(PG8_SB(0, 0), cB, voffB); PG8_STAGE(PG8_SB(0, 1), cB + hstep, voffB); PG8_STAGE(PG8_SA(0, 0), cA, voffA); PG8_STAGE(PG8_SA(0, 1), cA + hstep, voffA);
        if (wr == 1) PG8_BAR;
        PG8_WAIT_V(2); PG8_BAR;
        PG8_STAGE(PG8_SB(1, 0), cB + kstep, voffB); PG8_STAGE(PG8_SA(1, 0), cA + kstep, voffA); PG8_STAGE(PG8_SB(1, 1), cB + hstep + kstep, voffB);
        PG8_WAIT_V(6); PG8_BAR;
    } else {
        PG8_STAGE(PG8_SB(0, 0), cB, voffB); PG8_STAGE(PG8_SA(0, 0), cA, voffA); PG8_STAGE(PG8_SB(0, 1), cB + hstep, voffB); PG8_STAGE(PG8_SA(0, 1), cA + hstep, voffA);
        if (wr == 1) PG8_BAR;
        PG8_WAIT_V(4); PG8_BAR;
        PG8_STAGE(PG8_SB(1, 0), cB + kstep, voffB); PG8_STAGE(PG8_SA(1, 0), cA + kstep, voffA); PG8_STAGE(PG8_SB(1, 1), cB + hstep + kstep, voffB);
        PG8_WAIT_V(6); PG8_BAR;
    }
    for (;;) {
        const bool has_next = S.next(ui + 1, nxt);
        const char* nA = has_next ? (const char*)g.A + (size_t)nxt.pm * tstep + (size_t)nxt.kt0 * kstep : cA; const char* nB = has_next ? (const char*)g.Bt + (size_t)nxt.pn * tstep + (size_t)nxt.kt0 * kstep : cB;
        for (int t = 0; t < nt; t += 2) {
            const bool last = (t == nt - 2);
            const char* a1 = cA + (size_t)(t + 1) * kstep;
            const char* a2 = last ? nA : cA + (size_t)(t + 2) * kstep; const char* b2 = last ? nB : cB + (size_t)(t + 2) * kstep;
            const char* a3 = a2 + kstep; const char* b3 = b2 + kstep;
            if (last && has_next) S.a_ready(nxt);
            if constexpr (SP2) {
            PG8_LDB(B0, 0, 0); PG8_LDB(B1, 0, 1); PG8_SCHED; PG8_LDA(At, 0, 0); PG8_STAGE(PG8_SA(1, 1), a1 + hstep, voffA);
            PG8_WAIT_V(8); PG8_WAIT_L(0); PG8_BAR; PG8_MMA(0, 0, At, B0); PG8_MMA(0, 1, At, B1); PG8_BAR; PG8_SCHED;
            PG8_LDA(At, 0, 1); PG8_STAGE(PG8_SB(0, 0), b2, voffB); PG8_STAGE(PG8_SB(0, 1), b2 + hstep, voffB); PG8_STAGE(PG8_SA(0, 0), a2, voffA);
            PG8_WAIT_V(8); PG8_WAIT_L(0); PG8_BAR; PG8_MMA(1, 0, At, B0); PG8_MMA(1, 1, At, B1); PG8_BAR; PG8_SCHED;
            PG8_LDB(B0, 1, 0); PG8_LDB(B1, 1, 1); PG8_SCHED; PG8_LDA(At, 1, 0); PG8_STAGE(PG8_SA(0, 1), a2 + hstep, voffA);
            PG8_WAIT_V(8); PG8_WAIT_L(0); PG8_BAR; PG8_MMA(0, 0, At, B0); PG8_MMA(0, 1, At, B1); PG8_BAR; PG8_SCHED;
            PG8_LDA(At, 1, 1); PG8_STAGE(PG8_SB(1, 0), b3, voffB); PG8_STAGE(PG8_SB(1, 1), b3 + hstep, voffB); PG8_STAGE(PG8_SA(1, 0), a3, voffA);
            PG8_WAIT_V(8); PG8_WAIT_L(0); PG8_BAR; PG8_MMA(1, 0, At, B0); PG8_MMA(1, 1, At, B1); PG8_BAR; PG8_SCHED;
            } else {
            PG8_LDB(B0, 0, 0); PG8_SCHED; PG8_LDA(At, 0, 0); PG8_STAGE(PG8_SA(1, 1), a1 + hstep, voffA);
            PG8_WAIT_L(8); PG8_BAR; PG8_WAIT_L(0); PG8_MMA(0, 0, At, B0); PG8_BAR; PG8_SCHED;
            PG8_LDB(B1, 0, 1); PG8_STAGE(PG8_SB(0, 0), b2, voffB);
            PG8_BAR; PG8_WAIT_L(0); PG8_MMA(0, 1, At, B1); PG8_BAR;
            PG8_LDA(At, 0, 1); PG8_STAGE(PG8_SA(0, 0), a2, voffA);
            PG8_BAR; PG8_WAIT_L(0); PG8_MMA(1, 0, At, B0); PG8_BAR; PG8_SCHED;
            PG8_STAGE(PG8_SB(0, 1), b2 + hstep, voffB);
            PG8_WAIT_V(6); PG8_BAR; PG8_MMA(1, 1, At, B1); PG8_BAR;
            PG8_LDB(B0, 1, 0); PG8_SCHED; PG8_LDA(At, 1, 0); PG8_STAGE(PG8_SA(0, 1), a2 + hstep, voffA);
            PG8_WAIT_L(8); PG8_BAR; PG8_WAIT_L(0); PG8_MMA(0, 0, At, B0); PG8_BAR; PG8_SCHED;
            PG8_LDB(B1, 1, 1); PG8_STAGE(PG8_SB(1, 0), b3, voffB);
            PG8_BAR; PG8_WAIT_L(0); PG8_MMA(0, 1, At, B1); PG8_BAR;
            PG8_LDA(At, 1, 1); PG8_STAGE(PG8_SA(1, 0), a3, voffA);
            PG8_BAR; PG8_WAIT_L(0); PG8_MMA(1, 0, At, B0); PG8_BAR; PG8_SCHED;
            PG8_STAGE(PG8_SB(1, 1), b3 + hstep, voffB);
            PG8_WAIT_V(6); PG8_BAR; PG8_MMA(1, 1, At, B1); PG8_BAR;
            }
        }
        if constexpr (ALIGN_EPI) { if (wr == 0) PG8_BAR; }
        if constexpr (!Epi::AFTER_DRAIN) { E(acc, cur, wr, wc, fr, fq); S.done(cur); }
        if (!has_next) break;
#pragma unroll
        for (int a = 0; a < 2; ++a)
#pragma unroll
            for (int b = 0; b < 2; ++b)
#pragma unroll
                for (int m = 0; m < 4; ++m)
#pragma unroll
                    for (int n = 0; n < 2; ++n) acc[a][b][m][n] = (f32x4){0.f, 0.f, 0.f, 0.f};
        cur = nxt; cA = nA; cB = nB; ++ui; nt = cur.nk;
        if constexpr (ALIGN_EPI) { if (wr == 1) PG8_BAR; }
    }
    PG8_WAIT_V(0);
    if constexpr (!ALIGN_EPI) { if (wr == 0) PG8_BAR; }
    PG8_BAR;
    if constexpr (Epi::AFTER_DRAIN) { E.fused(acc, cur, wr, wc, fr, fq, lds, wid, lane); S.done(cur); }
#undef PG8_SA
#undef PG8_SB
#undef PG8_STAGE
#undef PG8_LDA
#undef PG8_LDB
#undef PG8_MMA
#undef PG8_WAIT_V
#undef PG8_WAIT_L
#undef PG8_BAR
#undef PG8_SCHED
}
}

#include <hip/hip_cooperative_groups.h>
namespace cg = cooperative_groups;
#define LAS __attribute__((address_space(3)))
typedef unsigned short bf16;
typedef unsigned u32x4 __attribute__((ext_vector_type(4)));
typedef unsigned u32x2 __attribute__((ext_vector_type(2)));
typedef float f32x4 __attribute__((ext_vector_type(4)));
typedef float f32x16 __attribute__((ext_vector_type(16)));
typedef short bf16x8 __attribute__((ext_vector_type(8)));
typedef short s16x4 __attribute__((ext_vector_type(4)));

constexpr int D = 1024, NB = 8, SEQ = 4096, CTX = 256, DFF = 2816, NLAT = NB * SEQ  , NTOK = NLAT + NB * CTX  , INW = 2048, NMOD = 9 * D;
constexpr float EPS = 1e-6f, QSCALE = 0.125f * 1.4426950408889634f, LAM_INIT = 0.2f;
constexpr size_t MiB = 1u << 20;
constexpr size_t WS_BAR = 512 * 1024, WS_MOD = 0, WS_W1A = 1 * MiB, WS_W2A = 12 * MiB, WS_W1B = 18 * MiB, WS_W2B = 29 * MiB, WS_WIN = 35 * MiB, WS_WOUT = 39 * MiB, WS_WP = 41 * MiB,
                 WS_HN = 48 * MiB, WS_X1 = 116 * MiB, WS_BIG = 252 * MiB, WS_END = 440 * MiB;
static_assert(WS_HN + (size_t)NTOK * D * 2 <= WS_X1 && WS_X1 + (size_t)NTOK * D * 4 <= WS_BIG && WS_BIG + (size_t)NTOK * DFF * 2 <= WS_END, "ws map");
constexpr int LDS_BYTES = 147456, NWAVES = 8, NPHASE = 12;
#ifndef MK_N_LAUNCHES
#define MK_N_LAUNCHES 1
#endif

__device__ __forceinline__ unsigned f2bf(float f) { unsigned u = __builtin_bit_cast(unsigned, f); return (u + 0x7fffu + ((u >> 16) & 1u)) >> 16; }
__device__ __forceinline__ unsigned pk2(float lo, float hi) { return f2bf(lo) | (f2bf(hi) << 16); }
__device__ __forceinline__ unsigned cvtpk(float lo, float hi) { unsigned r; asm volatile("v_cvt_pk_bf16_f32 %0, %1, %2" : "=v"(r) : "v"(lo), "v"(hi)); return r; }
__device__ __forceinline__ float bflo(unsigned w) { return __builtin_bit_cast(float, w << 16); }
__device__ __forceinline__ float bfhi(unsigned w) { return __builtin_bit_cast(float, w & 0xffff0000u); }
__device__ __forceinline__ float wave_sum(float v) {
#pragma unroll
    for (int o = 1; o < 64; o <<= 1) v += __shfl_xor(v, o);
    return v;
}
__device__ __forceinline__ int crow(int r, int hi) { return (r & 3) + 8 * (r >> 2) + 4 * hi; }

__device__ __forceinline__ void adaln_unit(LAS unsigned char* lds, int unit, const float* c, const float* c_ctx, const float* w_mod, const float* b_mod, float* mod, int tid) {
    LAS float* scond = (LAS float*)lds;
    LAS float* part = (LAS float*)(lds + 36864);
    for (int i = tid; i < 9 * D; i += 512) { const int r = i >> 10, k = i & 1023; const float v = (r < 8) ? c[r * D + k] : c_ctx[k]; scond[i] = v / (1.0f + __expf(-v)); }
    __syncthreads();
    const int cgp = tid & 15, ks = tid >> 4;
    f32x4 acc[9];
#pragma unroll
    for (int r = 0; r < 9; ++r) acc[r] = (f32x4){0.f, 0.f, 0.f, 0.f};
    const float* wp = w_mod + (size_t)(32 * ks) * NMOD + 64 * unit + 4 * cgp;
#pragma unroll 8
    for (int kk = 0; kk < 32; ++kk) { const f32x4 w = *(const f32x4*)(wp + (size_t)kk * NMOD);
#pragma unroll
        for (int r = 0; r < 9; ++r) acc[r] += w * scond[r * D + 32 * ks + kk]; }
#pragma unroll
    for (int r = 0; r < 9; ++r) *(LAS f32x4*)(part + (ks * 9 + r) * 64 + 4 * cgp) = acc[r];
    __syncthreads();
    for (int o = tid; o < 9 * 64; o += 512) { const int r = o >> 6, cc = o & 63; float s = 0.f;
#pragma unroll 8
        for (int k2 = 0; k2 < 32; ++k2) s += part[(k2 * 9 + r) * 64 + cc];
        mod[(size_t)r * NMOD + 64 * unit + cc] = s + b_mod[64 * unit + cc]; }
    __syncthreads();
}
__device__ __forceinline__ void transpose_item(const float* W, int ldw, bf16* WT, int ldt, int k0, int n0, int drow0, LAS float* scr, int lane) {
#pragma unroll 8
    for (int i = 0; i < 32; ++i) { const int kk = 2 * i + (lane >> 5); scr[kk * 33 + (lane & 31)] = W[(size_t)(k0 + kk) * ldw + n0 + (lane & 31)]; }
    asm volatile("s_waitcnt lgkmcnt(0)" ::: "memory");
    const int c = lane & 7;
#pragma unroll
    for (int j = 0; j < 4; ++j) { const int n = (lane >> 3) + 8 * j; const LAS float* s = scr + (8 * c) * 33 + n;
        u32x4 o; o.x = pk2(s[0 * 33], s[1 * 33]); o.y = pk2(s[2 * 33], s[3 * 33]); o.z = pk2(s[4 * 33], s[5 * 33]); o.w = pk2(s[6 * 33], s[7 * 33]);
        *(u32x4*)(WT + (size_t)(drow0 + n) * ldt + k0 + 8 * c) = o; }
    asm volatile("s_waitcnt lgkmcnt(0)" ::: "memory");
}
__device__ __forceinline__ void transpose_mat_item(const float* W, int K, int N, bf16* WT, bool swiglu, int item, LAS float* scr, int lane) {
    const int nblk = N / 32, kb = item / nblk, nb = item % nblk, n0 = 32 * nb; int drow0 = n0;
    if (swiglu) { const int half = N / 2; const int j = (n0 < half) ? n0 : n0 - half; drow0 = (j >> 7) * 256 + ((n0 < half) ? 0 : 128) + (j & 127); }
    transpose_item(W, N, WT, K, 64 * kb, n0, drow0, scr, lane);
}

__device__ __forceinline__ void norm_pass(const float* lat, const float* ctxp, int nrows, const float* g, const float* mod, int sh_i, int sc_i, bf16* dst, float* dstf, int wave, int lane, const float* part = nullptr, const float* pgate = nullptr, int row_begin = 0) {
    const int gw = blockIdx.x * NWAVES + wave, NGW = gridDim.x * NWAVES, nch = nrows >> 2;
    for (int ch = gw + (row_begin >> 2); ch < nch; ch += NGW) {
        const int row0 = ch * 4; const bool isl = row0 < NLAT; const int rix = isl ? (row0 >> 12) : 8;
        const float* src = isl ? lat + (size_t)row0 * D : ctxp + (size_t)(row0 - NLAT) * D;
        f32x4 gs[4], sh[4];
#pragma unroll
        for (int j = 0; j < 4; ++j) { const int col = 4 * lane + 256 * j; gs[j] = *(const f32x4*)(g + col);
            if (mod) { gs[j] = gs[j] * (*(const f32x4*)(mod + (size_t)rix * NMOD + sc_i * D + col) + 1.0f); sh[j] = *(const f32x4*)(mod + (size_t)rix * NMOD + sh_i * D + col); }
            else sh[j] = (f32x4){0.f, 0.f, 0.f, 0.f}; }
#pragma unroll
        for (int rr = 0; rr < 4; ++rr) {
            f32x4 v[4]; float ss = 0.f;
#pragma unroll
            for (int j = 0; j < 4; ++j) { v[j] = __builtin_nontemporal_load((const f32x4*)(src + (size_t)rr * D + 4 * lane + 256 * j));
                if (part && !isl) { const float* pp = part + (size_t)(row0 - NLAT + rr) * D + 4 * lane + 256 * j; const size_t ps = (size_t)2048 * 1024;
                    const f32x4 sp = (*(const f32x4*)pp + *(const f32x4*)(pp + ps)) + (*(const f32x4*)(pp + 2 * ps) + *(const f32x4*)(pp + 3 * ps));
                    v[j] = v[j] + sp * (*(const f32x4*)(pgate + 4 * lane + 256 * j) * 0.5f); }
                ss += (v[j].x * v[j].x + v[j].y * v[j].y) + (v[j].z * v[j].z + v[j].w * v[j].w); }
            const float rstd = 1.0f / sqrtf(wave_sum(ss) * (1.0f / D) + EPS);
#pragma unroll
            for (int j = 0; j < 4; ++j) { const f32x4 o = v[j] * rstd * gs[j] + sh[j]; const size_t off = (size_t)(row0 + rr) * D + 4 * lane + 256 * j;
                if (dstf) __builtin_nontemporal_store(o, (f32x4*)(dstf + off));
                else { u32x2 w; w.x = pk2(o.x, o.y); w.y = pk2(o.z, o.w); *(u32x2*)(dst + off) = w; } }
        }
    }
}

constexpr int PU_STRIDE = 320, PU_ROWS = 144, PO_OFF = PU_ROWS * PU_STRIDE  , PW_OFF = PO_OFF + 128 * 272  ;
__device__ __forceinline__ bf16x8 pfrag(const LAS unsigned char* p) { const s16x4 vl = __builtin_bit_cast(s16x4, __builtin_amdgcn_ds_read_tr16_b64_v4i16((LAS s16x4*)p)), vh = __builtin_bit_cast(s16x4, __builtin_amdgcn_ds_read_tr16_b64_v4i16((LAS s16x4*)(p + 8 * PU_STRIDE)));
    return (bf16x8){vl[0], vl[1], vl[2], vl[3], vh[0], vh[1], vh[2], vh[3]}; }
__device__ __forceinline__ void pool_load(int rb, int gi, const bf16* HX, const bf16* WPt, u32x4 (&v)[5], u32x4 (&wv)[4], int tid) {
    const int b = rb >> 5, t0 = (rb & 31) * 128;
#pragma unroll
    for (int k = 0; k < 5; ++k) { const int cidx = tid + 512 * k, i = cidx >> 4, ch = cidx & 15, t = t0 - 8 + i; v[k] = (u32x4){0u, 0u, 0u, 0u};
        if (cidx < PU_ROWS * 16 && t >= 0 && t < SEQ) v[k] = *(const u32x4*)(HX + (size_t)NTOK * 512 + ((size_t)gi * NTOK + (size_t)b * SEQ + t) * 128 + ch * 8); }
#pragma unroll
    for (int k = 0; k < 4; ++k) { const int cidx = tid + 512 * k; wv[k] = *(const u32x4*)(WPt + (size_t)gi * 128 * 128 + cidx * 8); }
}
__device__ __forceinline__ void pool_stage(LAS unsigned char* lds, const u32x4 (&v)[5], const u32x4 (&wv)[4], int tid) {
#pragma unroll
    for (int k = 0; k < 5; ++k) { const int cidx = tid + 512 * k, i = cidx >> 4, ch = cidx & 15; if (cidx < PU_ROWS * 16) *(LAS u32x4*)(lds + i * PU_STRIDE + ch * 16) = v[k]; }
#pragma unroll
    for (int k = 0; k < 4; ++k) { const int cidx = tid + 512 * k, n = cidx >> 4, ch = cidx & 15; *(LAS u32x4*)(lds + PW_OFF + n * 272 + ch * 16) = wv[k]; }
}
__device__ __forceinline__ void pool_compute(LAS unsigned char* lds, int rb, int gi, const float* pool_scale, bf16* MIX, int tid, int wave, int lane) {
    const int b = rb >> 5, t0 = (rb & 31) * 128, lo = 1 << gi;
    const int r32 = lane & 31, hi = lane >> 5, tb = wave & 3, half = wave >> 2;
    f32x16 acc[4]; acc[0] = f32x16{}; acc[1] = f32x16{}; acc[2] = f32x16{}; acc[3] = f32x16{};
    { const LAS unsigned char* ub = lds + (4 * hi + ((lane & 15) >> 2)) * PU_STRIDE + (16 * ((lane >> 4) & 1) + 4 * (lane & 3)) * 2;
#pragma unroll
      for (int ksl = 0; ksl < 3; ++ksl) { const int ks = 2 * tb + ksl;
          u32x4 bw;
#pragma unroll
          for (int jj = 0; jj < 4; ++jj) { const int j0 = 2 * jj, j1 = 2 * jj + 1;
              const int d0 = 16 * ks + 4 * hi + (j0 & 3) + 8 * (j0 >> 2) - 8 - (32 * tb + r32), d1 = 16 * ks + 4 * hi + (j1 & 3) + 8 * (j1 >> 2) - 8 - (32 * tb + r32);
              bw[jj] = ((d0 >= -lo && d0 < lo) ? 0x3F80u : 0u) | ((d1 >= -lo && d1 < lo) ? 0x3F800000u : 0u); }
          const bf16x8 bfr = __builtin_bit_cast(bf16x8, bw);
#pragma unroll
          for (int cb = 0; cb < 4; ++cb) acc[cb] = __builtin_amdgcn_mfma_f32_32x32x16_bf16(pfrag(ub + ks * 16 * PU_STRIDE + cb * 64), bfr, acc[cb], 0, 0, 0); } }
    bf16x8 dfr[8];
    { const int t = t0 + 32 * tb + r32; const int st = (t - lo > 0) ? t - lo : 0, en = (t + lo - 1 < SEQ - 1) ? t + lo - 1 : SEQ - 1; const float inv = 1.0f / (float)(en - st + 1);
      const LAS unsigned char* own = lds + (32 * tb + r32 + 8) * PU_STRIDE + 8 * hi;
#pragma unroll
      for (int cb = 0; cb < 4; ++cb) { u32x2 dw[4];
#pragma unroll
          for (int g4 = 0; g4 < 4; ++g4) { const u32x2 o2 = *(const LAS u32x2*)(own + (32 * cb + 8 * g4) * 2);
              dw[g4].x = cvtpk(acc[cb][4 * g4] * inv - bflo(o2.x), acc[cb][4 * g4 + 1] * inv - bfhi(o2.x)); dw[g4].y = cvtpk(acc[cb][4 * g4 + 2] * inv - bflo(o2.y), acc[cb][4 * g4 + 3] * inv - bfhi(o2.y)); }
          dfr[2 * cb] = __builtin_bit_cast(bf16x8, (u32x4){dw[0].x, dw[0].y, dw[1].x, dw[1].y}); dfr[2 * cb + 1] = __builtin_bit_cast(bf16x8, (u32x4){dw[2].x, dw[2].y, dw[3].x, dw[3].y}); } }
    f32x16 out[2]; out[0] = f32x16{}; out[1] = f32x16{};
#pragma unroll
    for (int nbl = 0; nbl < 2; ++nbl) { const LAS unsigned char* wrow = lds + PW_OFF + (32 * (2 * half + nbl) + r32) * 272 + 8 * hi;
#pragma unroll
        for (int kq = 0; kq < 8; ++kq) { const u32x2 a0 = *(const LAS u32x2*)(wrow + 32 * kq), a1 = *(const LAS u32x2*)(wrow + 32 * kq + 16);
            out[nbl] = __builtin_amdgcn_mfma_f32_32x32x16_bf16(__builtin_bit_cast(bf16x8, (u32x4){a0.x, a0.y, a1.x, a1.y}), dfr[kq], out[nbl], 0, 0, 0); } }
    { LAS unsigned char* ot = lds + PO_OFF + (32 * tb + r32) * 272;
#pragma unroll
      for (int nbl = 0; nbl < 2; ++nbl)
#pragma unroll
        for (int rq = 0; rq < 4; ++rq) { const int n0 = 32 * (2 * half + nbl) + 8 * rq + 4 * hi; const f32x4 ps = *(const f32x4*)(pool_scale + gi * 128 + n0);
            u32x2 w; w.x = cvtpk(out[nbl][4 * rq] * ps.x, out[nbl][4 * rq + 1] * ps.y); w.y = cvtpk(out[nbl][4 * rq + 2] * ps.z, out[nbl][4 * rq + 3] * ps.w);
            *(LAS u32x2*)(ot + n0 * 2) = w; } }
    __syncthreads();
#pragma unroll
    for (int k = 0; k < 4; ++k) { const int cidx = tid + 512 * k, row = cidx >> 4, ch = cidx & 15;
        *(u32x4*)(MIX + ((size_t)b * SEQ + t0 + row) * D + 512 + gi * 128 + ch * 8) = *(const LAS u32x4*)(lds + PO_OFF + row * 272 + ch * 16); }
}

constexpr int AK_STRIDE = 144, AV_STRIDE = 320, AK_BYTES = 64 * AK_STRIDE, AKS = 2 * AK_BYTES  , AVS = 64 * AV_STRIDE  , AV_BASE = 3 * AKS;
#define SBAR() __builtin_amdgcn_sched_barrier(0)
typedef float f32x2_t __attribute__((ext_vector_type(2))); typedef __bf16 bf16x2_t __attribute__((ext_vector_type(2)));
__device__ __forceinline__ unsigned cvtpk_s(float lo, float hi) { f32x2_t v = {lo, hi}; bf16x2_t bb = __builtin_convertvector(v, bf16x2_t); return __builtin_bit_cast(unsigned, bb); }
__device__ __forceinline__ s16x4 vtr(const LAS unsigned char* p) { return __builtin_bit_cast(s16x4, __builtin_amdgcn_ds_read_tr16_b64_v4i16((LAS s16x4*)p)); }
__device__ __forceinline__ bf16x8 vfrag(const LAS unsigned char* p) { const s16x4 vl = vtr(p), vh = vtr(p + 8 * AV_STRIDE); return (bf16x8){vl[0], vl[1], vl[2], vl[3], vh[0], vh[1], vh[2], vh[3]}; }
__device__ __forceinline__ void glds16(const void* gsrc, unsigned lds_dst) { unsigned keep;
    asm volatile("s_mov_b32 %0, m0\n\ts_mov_b32 m0, %2\n\ts_nop 0\n\tglobal_load_lds_dwordx4 %1, off\n\ts_mov_b32 m0, %0" : "=&s"(keep) : "v"(gsrc), "s"(lds_dst) : "memory"); }
__device__ __forceinline__ float max3f(float a, float b, float c) { float r; asm("v_max3_f32 %0, %1, %2, %3" : "=v"(r) : "v"(a), "v"(b), "v"(c)); return r; }
#define WAIT_BAR0() asm volatile("s_waitcnt vmcnt(0) lgkmcnt(0)\n\ts_barrier" ::: "memory")
#define WAIT_BAR5() asm volatile("s_waitcnt vmcnt(5) lgkmcnt(0)\n\ts_barrier" ::: "memory")
template <int MODE> __device__ __forceinline__ void attn_unit(LAS unsigned char* lds, int b, int h, int qb, const bf16* HQ, const bf16* KP, const bf16* VP, bf16* MIX, const float* g_sub, float lam, int tid, int wave, int lane) {
    const int r32 = lane & 31, hi = lane >> 5, map = wave >> 2, qw = wave & 3;
    const size_t qrow = (size_t)b * SEQ + qb * 128 + qw * 32 + r32;
    bf16x8 qf[4];
#pragma unroll
    for (int d0 = 0; d0 < 4; ++d0) qf[d0] = *(const bf16x8*)(HQ + qrow * 512 + h * 128 + map * 64 + d0 * 16 + hi * 8);
    unsigned soff[5], ldst[5]; bool isv[5], valid[5];
#pragma unroll
    for (int i = 0; i < 5; ++i) { const int bid = wave + 8 * i; valid[i] = bid < 38; isv[i] = bid >= 18;
        if (bid < 18) { const int km = bid / 9, j = bid % 9, p = 64 * j + lane, row = p / 9; int ch = p % 9; if (ch == 8) ch = 0;
            soff[i] = (unsigned)(row * 128 + km * 64 + ch * 8) * 2u; ldst[i] = km * AK_BYTES + j * 1024; }
        else { const int j = bid - 18, p = 64 * j + lane, row = p / 20; int ch = p % 20; if (ch >= 16) ch = 0;
            soff[i] = (unsigned)(row * 128 + ch * 8) * 2u; ldst[i] = j * 1024; } }
    if (!valid[4]) { soff[4] = soff[0]; ldst[4] = ldst[0]; isv[4] = isv[0]; valid[4] = true; }
    const unsigned lds0 = (unsigned)(uintptr_t)lds;
    const char* kbase = (const char*)(KP + (size_t)(b * 4 + h) * 4352 * 128); const char* vbase = (const char*)(VP + (size_t)(b * 4 + h) * 4352 * 128);
#define DMA_I(i, tk, sk, tv, sv, dok, dov) do { if (!(MODE & 2) && (isv[i] ? (dov) : (dok))) { const int tt_ = isv[i] ? (tv) : (tk); \
        glds16((isv[i] ? vbase : kbase) + (size_t)tt_ * 16384 + soff[i], (unsigned)__builtin_amdgcn_readfirstlane(lds0 + (isv[i] ? AV_BASE + (sv) * AVS : (sk) * AKS) + ldst[i])); } } while (0)
#define DMA_KV(tk, sk, tv, sv, dok, dov) do { DMA_I(0, tk, sk, tv, sv, dok, dov); DMA_I(1, tk, sk, tv, sv, dok, dov); DMA_I(2, tk, sk, tv, sv, dok, dov); DMA_I(3, tk, sk, tv, sv, dok, dov); DMA_I(4, tk, sk, tv, sv, dok, dov); } while (0)
    constexpr int NT = (SEQ + CTX) / 64;
    DMA_KV(0, 0, 0, 0, true, false);
    DMA_KV(1, 1, 0, 0, true, true);
    WAIT_BAR5();
    f32x16 o[4]; o[0] = f32x16{}; o[1] = f32x16{}; o[2] = f32x16{}; o[3] = f32x16{};
    const f32x16 zero16 = f32x16{};
    float mrun = -INFINITY, lrun = 0.f;
    const unsigned koff = map * AK_BYTES + r32 * AK_STRIDE + hi * 16;
    const unsigned voff = AV_BASE + (4 * hi + ((lane & 15) >> 2)) * AV_STRIDE + (16 * ((lane >> 4) & 1) + 4 * (lane & 3)) * 2;
    u32x4 pw[4];
    f32x16 X0, X1;
#define KFR(i) (*(const LAS bf16x8*)(kb_ + (1 - ((i) >> 2)) * 32 * AK_STRIDE + ((i) & 3) * 32))
#define VFR(i) vfrag(vb_ + ((i) >> 2) * 16 * AV_STRIDE + ((i) & 3) * 64)
#define GAPA(i, HASP) do { if ((i) + 3 < 8) kr[((i) + 3) & 3] = KFR((i) + 3); \
        if ((i) < 4) { X1 = __builtin_amdgcn_mfma_f32_32x32x16_bf16(kr[(i) & 3], qf[(i) & 3], ((i) & 3) ? X1 : zero16, 0, 0, 0); \
            if (HASP) { sacc += (X0[(4 * (i)) & 15] + X0[(4 * (i) + 1) & 15]) + (X0[(4 * (i) + 2) & 15] + X0[(4 * (i) + 3) & 15]); \
                pw[((i) >> 1) & 1][((i) & 1) * 2] = cvtpk_s(X0[(4 * (i)) & 15], X0[(4 * (i) + 1) & 15]); pw[((i) >> 1) & 1][((i) & 1) * 2 + 1] = cvtpk_s(X0[(4 * (i) + 2) & 15], X0[(4 * (i) + 3) & 15]); asm volatile("" : "+v"(sacc)); } } \
        else X0 = __builtin_amdgcn_mfma_f32_32x32x16_bf16(kr[(i) & 3], qf[(i) & 3], ((i) & 3) ? X0 : zero16, 0, 0, 0); \
        SBAR(); } while (0)
#define EXC_(v) do { if (MODE & 1) break; if ((v) < 16) X0[(v) & 15] = __builtin_amdgcn_exp2f(X0[(v) & 15] - mrun); else X1[(v) & 15] = __builtin_amdgcn_exp2f(X1[(v) & 15] - mrun); } while (0)
#define GAPB(i, HASP) do { if ((HASP) && !(MODE & 4)) { if ((i) + 3 < 16) vr[((i) + 3) & 3] = VFR((i) + 3); \
            o[(i) & 3] = __builtin_amdgcn_mfma_f32_32x32x16_bf16(vr[(i) & 3], __builtin_bit_cast(bf16x8, pw[(i) >> 2]), o[(i) & 3], 0, 0, 0); } \
        EXC_(2 * (i)); EXC_(2 * (i) + 1); if ((i) < 8) asm volatile("" : "+v"(X0)); else asm volatile("" : "+v"(X1)); SBAR(); } while (0)
#define STEP(t, s0, HASP, DOK, DOV, WAITB) do { \
        const int s1_ = ((s0) == 2) ? 0 : (s0) + 1, s2_ = ((s0) == 0) ? 2 : (s0) - 1;     \
        const LAS unsigned char* kb_ = lds + (s0) * AKS + koff; const LAS unsigned char* vb_ = lds + s2_ * AVS + voff; \
        DMA_KV((t) + 2, s2_, (t) + 1, s1_, DOK, DOV); \
        bf16x8 kr[4]; kr[0] = KFR(0); kr[1] = KFR(1); kr[2] = KFR(2); float sacc = 0.f; SBAR(); \
        GAPA(0, HASP); GAPA(1, HASP); GAPA(2, HASP); GAPA(3, HASP); GAPA(4, HASP); GAPA(5, HASP); GAPA(6, HASP); GAPA(7, HASP); \
        lrun += sacc; \
        bf16x8 vr[4]; if ((HASP) && !(MODE & 4)) { vr[0] = VFR(0); vr[1] = VFR(1); vr[2] = VFR(2); } \
        float mx = fmaxf(X0[0], X1[0]); \
        if (!(MODE & 1)) { _Pragma("unroll") for (int r_ = 1; r_ < 16; ++r_) mx = max3f(mx, X0[r_], X1[r_]); } \
        { auto rr_ = __builtin_amdgcn_permlane32_swap(__float_as_uint(mx), __float_as_uint(mx), false, false); mx = max3f(mx, __uint_as_float(rr_[0]), __uint_as_float(rr_[1])); } \
        const bool resc = __any(mx > mrun); const float mn = max3f(mrun, mrun, mx), fsc = __builtin_amdgcn_exp2f(mrun - mn); lrun *= fsc; mrun = mn;     \
        SBAR(); \
        GAPB(0, HASP); GAPB(1, HASP); GAPB(2, HASP); GAPB(3, HASP); GAPB(4, HASP); GAPB(5, HASP); GAPB(6, HASP); GAPB(7, HASP); \
        GAPB(8, HASP); GAPB(9, HASP); GAPB(10, HASP); GAPB(11, HASP); GAPB(12, HASP); GAPB(13, HASP); GAPB(14, HASP); GAPB(15, HASP); \
        if (resc) { _Pragma("unroll") for (int db_ = 0; db_ < 4; ++db_) o[db_] = o[db_] * fsc; } \
        { float st_ = 0.f; _Pragma("unroll") for (int r_ = 0; r_ < 16; ++r_) st_ += X1[r_]; lrun += st_; \
          pw[2] = (u32x4){cvtpk_s(X1[0], X1[1]), cvtpk_s(X1[2], X1[3]), cvtpk_s(X1[4], X1[5]), cvtpk_s(X1[6], X1[7])}; \
          pw[3] = (u32x4){cvtpk_s(X1[8], X1[9]), cvtpk_s(X1[10], X1[11]), cvtpk_s(X1[12], X1[13]), cvtpk_s(X1[14], X1[15])}; } \
        WAITB(); } while (0)
    STEP(0, 0, false, true, true, WAIT_BAR5);
    { int s0 = 1;
      for (int t = 1; t < NT - 2; ++t) { STEP(t, s0, true, true, true, WAIT_BAR5); s0 = (s0 == 2) ? 0 : s0 + 1; } }
    STEP(NT - 2, (NT - 2) % 3, true, false, true, WAIT_BAR0);
    STEP(NT - 1, (NT - 1) % 3, true, false, false, WAIT_BAR0);
    { float sacc = 0.f;
#pragma unroll
      for (int r = 0; r < 16; ++r) sacc += X0[r];
      lrun += sacc;
      pw[0] = (u32x4){cvtpk_s(X0[0], X0[1]), cvtpk_s(X0[2], X0[3]), cvtpk_s(X0[4], X0[5]), cvtpk_s(X0[6], X0[7])};
      pw[1] = (u32x4){cvtpk_s(X0[8], X0[9]), cvtpk_s(X0[10], X0[11]), cvtpk_s(X0[12], X0[13]), cvtpk_s(X0[14], X0[15])};
      const LAS unsigned char* vb_ = lds + ((NT - 1) % 3) * AVS + voff;
#pragma unroll
      for (int i = 0; i < 16; ++i) o[i & 3] = __builtin_amdgcn_mfma_f32_32x32x16_bf16(VFR(i), __builtin_bit_cast(bf16x8, pw[i >> 2]), o[i & 3], 0, 0, 0);
    }
    __syncthreads();
#undef DMA_I
#undef DMA_KV
#undef KFR
#undef VFR
#undef GAPA
#undef EXC_
#undef GAPB
#undef STEP
    lrun += __shfl_xor(lrun, 32);
    const float rl = 1.0f / lrun;
    LAS float* ex = (LAS float*)lds + qw * 4096;
    if (map == 1) {
#pragma unroll
        for (int db = 0; db < 4; ++db)
#pragma unroll
            for (int r = 0; r < 16; ++r) ex[(db * 16 + r) * 64 + lane] = o[db][r] * rl;
    }
    __syncthreads();
    if (map == 0) {
        float ss = 0.f;
#pragma unroll
        for (int db = 0; db < 4; ++db)
#pragma unroll
            for (int r = 0; r < 16; ++r) { const float v = o[db][r] * rl - lam * ex[(db * 16 + r) * 64 + lane]; o[db][r] = v; ss += v * v; }
        ss += __shfl_xor(ss, 32);
        const float rstd = (1.0f - LAM_INIT) / sqrtf(ss * (1.0f / 128.0f) + EPS);
        bf16* op = MIX + qrow * D + h * 128;
#pragma unroll
        for (int db = 0; db < 4; ++db)
#pragma unroll
            for (int rq = 0; rq < 4; ++rq) { const int d0 = 32 * db + 8 * rq + 4 * hi; const f32x4 gsv = *(const LAS f32x4*)(lds + 131072 + 2048 + d0 * 4);
                u32x2 w; w.x = cvtpk(o[db][4 * rq] * rstd * gsv.x, o[db][4 * rq + 1] * rstd * gsv.y); w.y = cvtpk(o[db][4 * rq + 2] * rstd * gsv.z, o[db][4 * rq + 3] * rstd * gsv.w);
                *(u32x2*)(op + d0) = w; }
    }
    __syncthreads();
}
#undef SBAR

#define XB_TMO      128
#define XB_XCNT(j)  (256  + 64 * (j))
#define XB_XSUB(j)  (1280 + 64 * (j))
#define XB_XGEN(j)  (2304 + 64 * (j))
#define XB_TOP      3328
#define XB_TOPGEN   3392
#define XCD_BAR_WORDS 3456
#define XB_SPIN_CAP (1u << 18)

__device__ __forceinline__ unsigned xb_ld(unsigned* p)              { return __hip_atomic_load(p, __ATOMIC_RELAXED, __HIP_MEMORY_SCOPE_AGENT); }
__device__ __forceinline__ unsigned xb_add(unsigned* p, unsigned v) { return __hip_atomic_fetch_add(p, v, __ATOMIC_RELAXED, __HIP_MEMORY_SCOPE_AGENT); }
__device__ __forceinline__ unsigned xb_xcc_id() { return (unsigned)__builtin_amdgcn_s_getreg((3 << 11) | 20) & 0xFu; }
#define XB_SPIN(cond, bar) do { unsigned _sp = 0; while (cond) { __builtin_amdgcn_s_sleep(1); \
    if ((++_sp & 255u) == 0u) { if (xb_ld(&(bar)[XB_TMO])) break; if (_sp > XB_SPIN_CAP) { atomicAdd(&(bar)[XB_TMO], 1u); break; } } } } while (0)

struct XcdBarrier {
    unsigned* bar; unsigned x;
    volatile LAS unsigned* st;
};

__device__ __forceinline__ XcdBarrier xcd_barrier_post(unsigned* bar, volatile LAS unsigned* st) {
    XcdBarrier b; b.bar = bar; b.x = xb_xcc_id(); b.st = st;
    if (threadIdx.x == 0) (void)xb_add(&bar[XB_XCNT(b.x)], 1u);
    return b;
}
__device__ __forceinline__ void xcd_barrier_complete(unsigned* bar, unsigned x, unsigned& nloc, unsigned& nx) {
    const unsigned G = gridDim.x * gridDim.y * gridDim.z;
    unsigned sum, cnt, mine, sp = 0u;
    for (;;) {
        sum = 0u; cnt = 0u; mine = 0u;
#pragma unroll
        for (unsigned j = 0; j < 16; ++j) { const unsigned c = xb_ld(&bar[XB_XCNT(j)]); sum += c; cnt += (c > 0u) ? 1u : 0u; mine = (j == x) ? c : mine; }
        if (sum == G) break;
        __builtin_amdgcn_s_sleep(1);
        if ((++sp & 255u) == 0u) { if (xb_ld(&bar[XB_TMO])) break; if (sp > XB_SPIN_CAP) { atomicAdd(&bar[XB_TMO], 1u); break; } }
    }
    nloc = mine > 0u ? mine : 1u; nx = cnt > 0u ? cnt : 1u;
}

__device__ __forceinline__ void xcd_barrier(const XcdBarrier& b) {
    asm volatile("s_waitcnt vmcnt(0)" ::: "memory");
    __syncthreads();
    if (threadIdx.x == 0) {
        unsigned* bar = b.bar;
        __builtin_amdgcn_s_waitcnt(0);
        unsigned nloc = b.st[0], nx = b.st[1];
        if (nloc == 0u) { xcd_barrier_complete(bar, b.x, nloc, nx); b.st[0] = nloc; b.st[1] = nx; }
        const unsigned old = xb_add(&bar[XB_XSUB(b.x)], 1u);
        const unsigned gen = old / nloc;
        if (old + 1u == (gen + 1u) * nloc) {
            __builtin_amdgcn_fence(__ATOMIC_RELEASE, "agent");
            asm volatile("s_waitcnt vmcnt(0)" ::: "memory");
            const unsigned og = xb_add(&bar[XB_TOP], 1u);
            const unsigned tg = og / nx;
            if (og + 1u == (tg + 1u) * nx) xb_add(&bar[XB_TOPGEN], 1u);
            else XB_SPIN(xb_ld(&bar[XB_TOPGEN]) == tg, bar);
            __builtin_amdgcn_fence(__ATOMIC_ACQUIRE, "agent");
            xb_add(&bar[XB_XGEN(b.x)], 1u);
            asm volatile("s_waitcnt vmcnt(0)" ::: "memory");
        } else {
            XB_SPIN(xb_ld(&bar[XB_XGEN(b.x)]) == gen, bar);
            __builtin_amdgcn_fence(__ATOMIC_ACQUIRE, "agent");
            asm volatile("s_waitcnt vmcnt(0)" ::: "memory");
        }
    }
    __syncthreads();
}

struct Args { const float* in[23]; float* out; unsigned char* ws; int ph_lo, ph_hi; };
__global__ void __launch_bounds__(NWAVES * 64, 2) mk_fwd(Args a) {
    extern __shared__ __attribute__((aligned(16))) unsigned char lds_raw[];
    LAS unsigned char* lds = (LAS unsigned char*)lds_raw;
    const int tid = threadIdx.x, lane = tid & 63, wave = __builtin_amdgcn_readfirstlane(tid >> 6), G = gridDim.x, bx = blockIdx.x;
    unsigned char* ws = a.ws;
    const float *x = a.in[0], *c = a.in[1], *ctx = a.in[2], *c_ctx = a.in[3], *w_mod = a.in[4], *b_mod = a.in[5], *g_ffn1 = a.in[6], *ffn1_w_in = a.in[7], *ffn1_w_out = a.in[8],
                *g_mix = a.in[9], *w_in = a.in[10], *lq1 = a.in[11], *lk1 = a.in[12], *lq2 = a.in[13], *lk2 = a.in[14], *g_sub = a.in[15], *w_pool = a.in[16], *pool_scale = a.in[17],
                *w_out = a.in[18], *g_ffn2 = a.in[19], *ffn2_w_in = a.in[20], *ffn2_w_out = a.in[21], *g_final = a.in[22];
    float* mod = (float*)(ws + WS_MOD);
    bf16 *W1A = (bf16*)(ws + WS_W1A), *W2A = (bf16*)(ws + WS_W2A), *W1B = (bf16*)(ws + WS_W1B), *W2B = (bf16*)(ws + WS_W2B), *WINt = (bf16*)(ws + WS_WIN), *WOUTt = (bf16*)(ws + WS_WOUT), *WPt = (bf16*)(ws + WS_WP);
    bf16 *HN = (bf16*)(ws + WS_HN), *MIX = (bf16*)(ws + WS_HN), *ACT = (bf16*)(ws + WS_BIG), *HX = (bf16*)(ws + WS_BIG)  , *KP = (bf16*)(ws + WS_BIG + 68 * MiB), *VP = (bf16*)(ws + WS_BIG + 102 * MiB);
    float* X1 = (float*)(ws + WS_X1);
    float* xpart = (float*)(ws + 44 * MiB); unsigned* xcnt = (unsigned*)(ws + 700 * 1024);
    constexpr int I1 = (D / 64) * (2 * DFF / 32), I2 = (DFF / 64) * (D / 32), I3 = (D / 64) * (INW / 32), I4 = (D / 64) * (D / 32), I5 = 4 * 2 * 4;
#define CONV_RANGE(ilo, ihi, first_wg) do { const int fw_ = ((first_wg) < G) ? (first_wg) : 0; if (bx >= fw_) { LAS float* scr = (LAS float*)(lds + wave * 16384); \
        for (int it = (ilo) + (bx - fw_) * NWAVES + wave; it < (ihi); it += (G - fw_) * NWAVES) { int r = it; \
            if (r < I1) { transpose_mat_item(ffn1_w_in, D, 2 * DFF, W1A, true, r, scr, lane); continue; } r -= I1; \
            if (r < I1) { transpose_mat_item(ffn2_w_in, D, 2 * DFF, W1B, true, r, scr, lane); continue; } r -= I1; \
            if (r < I2) { transpose_mat_item(ffn1_w_out, DFF, D, W2A, false, r, scr, lane); continue; } r -= I2; \
            if (r < I2) { transpose_mat_item(ffn2_w_out, DFF, D, W2B, false, r, scr, lane); continue; } r -= I2; \
            if (r < I3) { transpose_mat_item(w_in, D, INW, WINt, false, r, scr, lane); continue; } r -= I3; \
            if (r < I4) { transpose_mat_item(w_out, D, D, WOUTt, false, r, scr, lane); continue; } r -= I4; \
            { const int gi = r >> 3; transpose_mat_item(w_pool + (size_t)gi * 128 * 128, 128, 128, WPt + (size_t)gi * 128 * 128, false, r & 7, scr, lane); } } } } while (0)
    const int lo = a.ph_lo, hi = a.ph_hi;
#define IN(k) (lo <= (k) && (k) < hi)
#define SEAM(k) do { if (IN(k) && IN((k) + 1)) xcd_barrier(bar); } while (0)

    if (tid < 4) ((volatile LAS unsigned*)(lds + 131072 + 64))[tid] = 0u;
    __syncthreads();
    if (IN(0)) {
        if (bx == 0) for (int i = tid; i < XCD_BAR_WORDS; i += 512) ((unsigned*)(ws + WS_BAR))[i] = 0u;
        for (int i = bx * 512 + tid; i < 3 * 128 * 64; i += G * 512) xcnt[i] = 0u;
        for (int u = bx; u < 144; u += G) adaln_unit(lds, u, c, c_ctx, w_mod, b_mod, mod, tid);
        CONV_RANGE(0, I1, 0); CONV_RANGE(2 * I1, 2 * I1 + I2, 0);
    }
    XcdBarrier bar; bar.bar = (unsigned*)(ws + WS_BAR); bar.x = 0; bar.st = nullptr;
    if (IN(0) && IN(1)) {
        cg::this_grid().sync();
        bar.bar = (unsigned*)(ws + WS_BAR); bar.x = xb_xcc_id(); bar.st = (volatile LAS unsigned*)(lds + 131072 + 64);
        if (tid == 0) bar.st[2] = xb_add(&bar.bar[XB_XCNT(bar.x)], 1u);
    }
    if (IN(1)) norm_pass(x, ctx, NTOK, g_ffn1, mod, 0, 1, HN, nullptr, wave, lane);
    SEAM(1);
    if (IN(2)) { pg8::Gemm g{HN, W1A, NTOK, 2 * DFF, D}; pg8::StaticOrder S; S.init(NTOK, 2 * DFF, G, bx, D); pg8::EpiSwiglu E{ACT, DFF};
        pg8::gemm_phase<pg8::EpiSwiglu, pg8::StaticOrder, true, true>(lds, g, S, E);
        CONV_RANGE(2 * I1 + 2 * I2, 2 * I1 + 2 * I2 + I3 + I4 + I5, ((NTOK / 256) * (2 * DFF / 256)) % G); }
    SEAM(2);
    if (IN(3)) { pg8::Gemm g{ACT, W2A, NTOK, D, DFF};
        { pg8::StaticOrder S; S.init(NLAT, D, G, bx, DFF);
          pg8::EpiResidRms<1, false> E{x, X1, mod + 2 * D, g_mix, mod + 4 * D, mod + 3 * D, HN, xpart, xcnt, (PG8_LAS float*)(lds + 131072 + 1024), nullptr};
          pg8::gemm_phase<pg8::EpiResidRms<1, false>, pg8::StaticOrder, true, true>(lds, g, S, E); }
        { pg8::SplitOnlyOrder S; S.init(NLAT, G, bx);
          pg8::EpiSplitRaw E{a.out};
          pg8::gemm_phase<pg8::EpiSplitRaw, pg8::SplitOnlyOrder, true, true>(lds, g, S, E); }
        CONV_RANGE(2 * I1 + I2, 2 * I1 + 2 * I2, 128); }
    SEAM(3);
    if (IN(4)) norm_pass(X1, ctx, NTOK, g_mix, mod, 3, 4, HN, nullptr, wave, lane, a.out, mod + (size_t)8 * NMOD + 2 * D, NLAT);
    SEAM(4);
    if (IN(5)) { pg8::Gemm g{HN, WINt, NTOK, INW, D}; pg8::StaticOrder S; S.init(NTOK, INW, G, bx, D); pg8::EpiInproj E{HX, KP, VP, QSCALE};
        pg8::gemm_phase<pg8::EpiInproj, pg8::StaticOrder, true, true>(lds, g, S, E);
        CONV_RANGE(I1, 2 * I1, ((NTOK / 256) * (INW / 256)) % G); }
    SEAM(5);
    if (IN(6)) {
        { u32x4 pv[5], pw_[4]; int u = bx;
          if (u < 1024) pool_load(u >> 2, (u + (u >> 8)) & 3, HX, WPt, pv, pw_, tid);
          for (; u < 1024; u += G) { pool_stage(lds, pv, pw_, tid); __syncthreads();
              const int un = u + G; if (un < 1024) pool_load(un >> 2, (un + (un >> 8)) & 3, HX, WPt, pv, pw_, tid);
              pool_compute(lds, u >> 2, (u + (u >> 8)) & 3, pool_scale, MIX, tid, wave, lane); } }
        __syncthreads();
        float d1 = 0.f, d2 = 0.f;
        for (int i = 0; i < 64; ++i) { d1 += lq1[i] * lk1[i]; d2 += lq2[i] * lk2[i]; }
        if (tid < 128) ((LAS float*)(lds + 131072 + 2048))[tid] = g_sub[tid];
        const float lam = __expf(d1) - __expf(d2) + LAM_INIT;
        int xcd = bx & 7, j = bx >> 3;
        if (IN(0)) {
            bool okc = (G == 256);
            for (int q = 0; q < 8; ++q) okc = okc && (xb_ld(&bar.bar[XB_XCNT(q)]) == 32u);
            if (okc && bar.x < 8u) { xcd = (int)bar.x; j = (int)((volatile LAS unsigned*)(lds + 131072 + 64))[2]; }
        }
        for (int u = j; u < 128; u += (G >> 3)) { const int bh = 4 * xcd + (u >> 5), qb = u & 31; attn_unit<0>(lds, bh >> 2, bh & 3, qb, HX, KP, VP, MIX, g_sub, lam, tid, wave, lane); }
    }
    SEAM(6);
    if (IN(7)) { pg8::Gemm g{MIX, WOUTt, NLAT, D, D}; pg8::StaticOrder S; S.init(NLAT, D, G, bx, D);
        pg8::EpiResidRms<2, false> E{X1, X1, mod + 5 * D, g_ffn2, mod + 7 * D, mod + 6 * D, (bf16*)a.out, xpart, xcnt + 1 * 128 * 64, (PG8_LAS float*)(lds + 131072 + 1024), nullptr};
        pg8::gemm_phase<pg8::EpiResidRms<2, false>, pg8::StaticOrder, true, true>(lds, g, S, E); }
    SEAM(7);
    if (IN(9)) { pg8::Gemm g{(const bf16*)a.out, W1B, NLAT, 2 * DFF, D}; pg8::StaticOrder S; S.init(NLAT, 2 * DFF, G, bx, D); pg8::EpiSwiglu E{ACT, DFF};
        pg8::gemm_phase<pg8::EpiSwiglu, pg8::StaticOrder, true, true>(lds, g, S, E); }
    SEAM(9);
    if (IN(10)) { pg8::Gemm g{ACT, W2B, NLAT, D, DFF}; pg8::StaticOrder S; S.init(NLAT, D, G, bx, DFF);
        pg8::EpiResidRms<1, true> E{X1, a.out, mod + 8 * D, g_final, nullptr, nullptr, nullptr, xpart, xcnt + 2 * 128 * 64, (PG8_LAS float*)(lds + 131072 + 1024), nullptr};
        pg8::gemm_phase<pg8::EpiResidRms<1, true>, pg8::StaticOrder, true, true>(lds, g, S, E); }
#undef IN
#undef CONV_RANGE
#undef SEAM
}

extern "C" void kernel_launch(void* const* d_in, const int* in_sizes, int n_in, void* d_out, int out_size, void* d_ws, size_t ws_size, hipStream_t stream) {
    static int grid = 0;
    if (grid == 0) {
        if (n_in != 23 || in_sizes[0] != NLAT * D || out_size != NLAT * D || ws_size < WS_END) { fprintf(stderr, "kernel_launch: unexpected shapes (n_in %d, in0 %d, out %d, ws %zu)\n", n_in, n_in > 0 ? in_sizes[0] : -1, out_size, ws_size); grid = -1; return; }
        int dev = 0, cus = 0, per_cu = 0;
        if (hipGetDevice(&dev) != hipSuccess || hipDeviceGetAttribute(&cus, hipDeviceAttributeMultiprocessorCount, dev) != hipSuccess) { grid = -1; return; }
        if (hipFuncSetAttribute((const void*)mk_fwd, hipFuncAttributeMaxDynamicSharedMemorySize, LDS_BYTES) != hipSuccess) { fprintf(stderr, "kernel_launch: hipFuncSetAttribute failed\n"); grid = -1; return; }
        if (hipOccupancyMaxActiveBlocksPerMultiprocessor(&per_cu, (const void*)mk_fwd, NWAVES * 64, LDS_BYTES) != hipSuccess || per_cu < 1) { fprintf(stderr, "kernel_launch: occupancy query says %d blocks/CU\n", per_cu); grid = -1; (void)hipGetLastError(); return; }
        grid = cus;
    }
    if (grid < 0) return;
    Args a{};
    for (int i = 0; i < 23; ++i) a.in[i] = (const float*)d_in[i];
    a.out = (float*)d_out; a.ws = (unsigned char*)d_ws;
#if MK_N_LAUNCHES == 1
    a.ph_lo = 0; a.ph_hi = NPHASE;
    void* args[] = {&a};
    hipError_t e = hipLaunchCooperativeKernel((const void*)mk_fwd, dim3(grid), dim3(NWAVES * 64), args, LDS_BYTES, stream);
    if (e != hipSuccess) fprintf(stderr, "kernel_launch: cooperative launch failed: %s (grid %d)\n", hipGetErrorString(e), grid);
#else
    for (int p = 0; p < NPHASE; ++p) { a.ph_lo = p; a.ph_hi = p + 1; hipLaunchKernelGGL(mk_fwd, dim3(grid), dim3(NWAVES * 64), LDS_BYTES, stream, a); }
#endif
}
```

```cpp
#include <hip/hip_runtime.h>
#include <cstdio>
#include <cstdint>
#include <cmath>
namespace pg8 {
#define PG8_LAS __attribute__((address_space(3)))
typedef unsigned short bf16_t;
typedef short bf16x8 __attribute__((ext_vector_type(8)));
typedef float f32x4 __attribute__((ext_vector_type(4)));
typedef unsigned u32x4 __attribute__((ext_vector_type(4)));
constexpr int BM = 256, BK = 64, HALF = 128, HTB = HALF * BK * 2  , STAGE_BYTES = 8 * HTB, NXCD = 8, WGM = 8;

__host__ __device__ __forceinline__ int lds_byte(int r, int c) { const int st = (r >> 4) * 2 + (c >> 5), rr = r & 15, cc = c & 31, ob = rr * 64 + cc * 2; return st * 1024 + (ob ^ (((ob >> 9) & 1) << 5)); }
__host__ __device__ __forceinline__ void stage_rc(int b, int& R, int& C) { const int st = b / 1024, sb = b % 1024, swz = sb ^ (((sb >> 9) & 1) << 5); R = (st >> 1) * 16 + swz / 64; C = (st & 1) * 32 + (swz % 64) / 2; }
__host__ __device__ __forceinline__ int perm32(int rho) { const int n = rho >> 4, i = rho & 15; return 8 * (i >> 2) + 4 * n + (i & 3); }

struct Unit { int pm, pn, kt0, nk; };
struct Gemm { const bf16_t* A; const bf16_t* Bt; int M, N, K; };

struct StaticOrder {
    int nM, nN, nwg, G, c, nkt;
    __host__ __device__ void init(int M, int N, int G_, int c_, int K_) { nM = M / BM; nN = N / BM; nwg = nM * nN; G = G_; c = c_; nkt = K_ / BK; }
    __host__ __device__ bool next(int i, Unit& u) const {
        const long L = (long)i * G + c; if (L >= nwg) return false;
        int wgid = (int)L; { const int q = nwg / NXCD, r = nwg % NXCD, xcd = wgid % NXCD, off = wgid / NXCD; wgid = (xcd < r ? xcd * (q + 1) : r * (q + 1) + (xcd - r) * q) + off; }
        const int nig = WGM * nN, gid = wgid / nig, fm = gid * WGM, gsz = (nM - fm) < WGM ? (nM - fm) : WGM;
        u.pm = fm + ((wgid % nig) % gsz); u.pn = (wgid % nig) / gsz; u.kt0 = 0; u.nk = nkt; return true;
    }
    __device__ __forceinline__ void a_ready(const Unit&) const {}
    __device__ __forceinline__ void done(const Unit&) const {}
};

struct SplitOrder {
    StaticOrder S; int nfull, G, c;
    __host__ __device__ void init(int Mlat, int N, int G_, int c_, int K_) { S.init(Mlat, N, G_, c_, K_); nfull = S.nwg; G = G_; c = c_; }
    __host__ __device__ bool next(int i, Unit& u) const {
        const long L = (long)i * G + c;
        if (L < nfull) return S.next(i, u);
        const int idx = (int)(L - nfull); if (idx >= 128) return false;
        const int un = idx >> 2, s = idx & 3; u.pm = S.nM + (un >> 2); u.pn = un & 3; u.kt0 = 12 * s; u.nk = (s == 3) ? 8 : 12; return true;
    }
    __device__ __forceinline__ void a_ready(const Unit&) const {}
    __device__ __forceinline__ void done(const Unit&) const {}
};
struct SplitOnlyOrder {
    int nMlat, G, c;
    __host__ __device__ void init(int Mlat, int G_, int c_) { nMlat = Mlat / BM; G = G_; c = c_; }
    __host__ __device__ bool next(int i, Unit& u) const {
        const long L = (long)i * G + c; if (L >= 128) return false;
        const int idx = (int)L, un = idx >> 2, s = idx & 3; u.pm = nMlat + (un >> 2); u.pn = un & 3; u.kt0 = 12 * s; u.nk = (s == 3) ? 8 : 12; return true;
    }
    __device__ __forceinline__ void a_ready(const Unit&) const {}
    __device__ __forceinline__ void done(const Unit&) const {}
};
__device__ __forceinline__ unsigned cvt_pk_bf16(float lo, float hi) { unsigned r; asm volatile("v_cvt_pk_bf16_f32 %0, %1, %2" : "=v"(r) : "v"(lo), "v"(hi)); return r; }
typedef float f32x2 __attribute__((ext_vector_type(2)));
__device__ __forceinline__ f32x2 gelu_pk(f32x2 v) {
    const f32x2 av = __builtin_elementwise_abs(v), d = av * 0.2316418882f + 1.0f;
    f32x2 t; t.x = __builtin_amdgcn_rcpf(d.x); t.y = __builtin_amdgcn_rcpf(d.y);
    f32x2 q = t * 0.5307027145f + (-0.7265760135f); q = q * t + 0.7107068705f; q = q * t + (-0.142248368f); q = q * t + 0.127414796f; q = q * t;
    const f32x2 s = (v * v) * (-0.72134752044f);
    f32x2 e; e.x = __builtin_amdgcn_exp2f(s.x); e.y = __builtin_amdgcn_exp2f(s.y);
    const f32x2 m = v * (q * e), r = v - m;
    f32x2 o; o.x = v.x < 0.f ? m.x : r.x; o.y = v.y < 0.f ? m.y : r.y; return o;
}

typedef unsigned u32x2 __attribute__((ext_vector_type(2)));
__device__ __forceinline__ float silu_f(float g) { return g * __builtin_amdgcn_rcpf(1.0f + __builtin_amdgcn_exp2f(-1.4426950408889634f * g)); }
struct EpiSwiglu {
    static constexpr bool PERM = true, AFTER_DRAIN = false;
    bf16_t* O; int ldo;
    __device__ __forceinline__ void operator()(const f32x4 (&acc)[2][2][4][2], const Unit& u, int wr, int wc, int fr, int fq) const {
        const int row0 = u.pm * BM + wr * 64 + fr, col0 = u.pn * HALF + wc * 32 + 8 * fq;
#pragma unroll
        for (int ai = 0; ai < 2; ++ai)
#pragma unroll
            for (int m = 0; m < 4; ++m) {
                bf16_t* p = O + (size_t)(row0 + ai * HALF + m * 16) * ldo + col0;
                const f32x4 g0 = acc[ai][0][m][0], g1 = acc[ai][0][m][1], u0 = acc[ai][1][m][0], u1 = acc[ai][1][m][1];
                u32x4 w;
                w.x = cvt_pk_bf16(silu_f(g0[0]) * u0[0], silu_f(g0[1]) * u0[1]); w.y = cvt_pk_bf16(silu_f(g0[2]) * u0[2], silu_f(g0[3]) * u0[3]);
                w.z = cvt_pk_bf16(silu_f(g1[0]) * u1[0], silu_f(g1[1]) * u1[1]); w.w = cvt_pk_bf16(silu_f(g1[2]) * u1[2], silu_f(g1[3]) * u1[3]);
                __builtin_nontemporal_store(w, (u32x4*)p);
            }
    }
};
struct EpiResid {
    static constexpr bool PERM = false, AFTER_DRAIN = false;
    const float* rlat; const float* rctx; float* out; const float* gate  ; float coef;
    __device__ __forceinline__ void operator()(const f32x4 (&acc)[2][2][4][2], const Unit& u, int wr, int wc, int fr, int fq) const {
        const bool lat = u.pm < 128; const int rix = lat ? (u.pm >> 4) : 8;
        const float* rb = lat ? rlat + (size_t)u.pm * BM * 1024 : rctx + (size_t)(u.pm - 128) * BM * 1024;
        float* ob = out + (size_t)u.pm * BM * 1024;
        const int col0 = u.pn * BM + wc * 32 + 4 * fq;
        f32x4 gv[2][2];
#pragma unroll
        for (int bj = 0; bj < 2; ++bj)
#pragma unroll
            for (int n = 0; n < 2; ++n) gv[bj][n] = *(const f32x4*)(gate + (size_t)rix * 9216 + col0 + bj * HALF + n * 16) * coef;
#pragma unroll
        for (int ai = 0; ai < 2; ++ai)
#pragma unroll
            for (int m = 0; m < 4; ++m) { const size_t off = (size_t)(ai * HALF + wr * 64 + m * 16 + fr) * 1024 + col0;
#pragma unroll
                for (int bj = 0; bj < 2; ++bj)
#pragma unroll
                    for (int n = 0; n < 2; ++n) { const f32x4 r = *(const f32x4*)(rb + off + bj * HALF + n * 16);
                        *(f32x4*)(ob + off + bj * HALF + n * 16) = r + gv[bj][n] * acc[ai][bj][m][n]; }
                if (m & 1) asm volatile("" ::: "memory"); }
    }
};
struct EpiResidS {
    static constexpr bool PERM = false, AFTER_DRAIN = false;
    const float* rlat; float* out; const float* gate; float* part;
    __device__ __forceinline__ void operator()(const f32x4 (&acc)[2][2][4][2], const Unit& u, int wr, int wc, int fr, int fq) const {
        const float* rlat_ = rlat; float* out_ = out; const float* gate_ = gate; float* part_ = part;
        const int col0 = u.pn * BM + wc * 32 + 4 * fq;
        if (u.pm >= 128) {
            float* pb = part_ + (size_t)(u.kt0 / 12) * (2048 * 1024) + (size_t)(u.pm - 128) * BM * 1024;
#pragma unroll
            for (int ai = 0; ai < 2; ++ai)
#pragma unroll
                for (int m = 0; m < 4; ++m) { const size_t off = (size_t)(ai * HALF + wr * 64 + m * 16 + fr) * 1024 + col0;
#pragma unroll
                    for (int bj = 0; bj < 2; ++bj)
#pragma unroll
                        for (int n = 0; n < 2; ++n) *(f32x4*)(pb + off + bj * HALF + n * 16) = acc[ai][bj][m][n]; }
            return;
        }
        const int rix = u.pm >> 4;
        const float* rb = rlat_ + (size_t)u.pm * BM * 1024; float* ob = out_ + (size_t)u.pm * BM * 1024;
        f32x4 gv[2][2];
#pragma unroll
        for (int bj = 0; bj < 2; ++bj)
#pragma unroll
            for (int n = 0; n < 2; ++n) gv[bj][n] = *(const f32x4*)(gate_ + (size_t)rix * 9216 + col0 + bj * HALF + n * 16) * 0.5f;
#pragma unroll
        for (int ai = 0; ai < 2; ++ai)
#pragma unroll
            for (int m = 0; m < 4; ++m) { const size_t off = (size_t)(ai * HALF + wr * 64 + m * 16 + fr) * 1024 + col0;
#pragma unroll
                for (int bj = 0; bj < 2; ++bj)
#pragma unroll
                    for (int n = 0; n < 2; ++n) { const f32x4 r = *(const f32x4*)(rb + off + bj * HALF + n * 16);
                        *(f32x4*)(ob + off + bj * HALF + n * 16) = r + gv[bj][n] * acc[ai][bj][m][n]; }
                if (m & 1) asm volatile("" ::: "memory"); }
    }
};
template <int COEF2, bool FINAL> struct EpiResidRms {
    static constexpr bool PERM = false, AFTER_DRAIN = false;
    const float* resid; float* xout; const float* gate; const float* g; const float* scm; const float* shm; bf16_t* hn; float* part; unsigned* cnt; PG8_LAS float* tab; float* splitpart  ;
    __device__ __forceinline__ void operator()(const f32x4 (&acc_c)[2][2][4][2], const Unit& u, int wr, int wc, int fr_in, int fq_in) const {
        f32x4 (&acc)[2][2][4][2] = const_cast<f32x4 (&)[2][2][4][2]>(acc_c);
        int fr = fr_in, fq = fq_in; asm volatile("" : "+v"(fr), "+v"(fq));
        if (splitpart != nullptr && u.pm >= 128) {
            float* sb = splitpart + (size_t)(u.kt0 / 12) * (2048 * 1024) + (size_t)(u.pm - 128) * BM * 1024; const int c0 = u.pn * BM + wc * 32 + 4 * fq;
#pragma unroll
            for (int ai = 0; ai < 2; ++ai)
#pragma unroll
                for (int m = 0; m < 4; ++m) { const size_t off = (size_t)(ai * HALF + wr * 64 + m * 16 + fr) * 1024 + c0;
#pragma unroll
                    for (int bj = 0; bj < 2; ++bj)
#pragma unroll
                        for (int n = 0; n < 2; ++n) *(f32x4*)(sb + off + bj * HALF + n * 16) = acc[ai][bj][m][n]; }
            return;
        }
        const float* resid_ = resid; float* xout_ = xout; const float* gate_ = gate; const float* g_ = g; const float* scm_ = scm; const float* shm_ = shm; bf16_t* hn_ = hn; float* part_ = part; unsigned* cnt_ = cnt; PG8_LAS float* tab_ = tab;
        const int rix = u.pm >> 4, col0 = u.pn * BM + wc * 32 + 4 * fq, wid = wr * 4 + wc, lane = fq * 16 + fr, tid = wid * 64 + lane;
        const float* rb = resid_ + (size_t)u.pm * BM * 1024; float* pb = part_ + (size_t)u.pm * BM * 16 + u.pn * 4 + wc;
        PG8_LAS float* vec = tab_ + 384; const int cl = wc * 32 + 4 * fq;
        if (tid < 256) { const int c = u.pn * BM + tid; vec[tid] = gate_[(size_t)rix * 9216 + c] * (0.5f * COEF2);
            if (FINAL) vec[256 + tid] = g_[c]; else { vec[256 + tid] = g_[c] * (scm_[(size_t)rix * 9216 + c] + 1.0f); vec[512 + tid] = shm_[(size_t)rix * 9216 + c]; } }
        asm volatile("s_waitcnt vmcnt(0) lgkmcnt(0)" ::: "memory"); __builtin_amdgcn_s_barrier(); asm volatile("" ::: "memory");
        {
#pragma unroll
          for (int ap = 0; ap < 4; ++ap) { const int ai = ap >> 1, m0 = (ap & 1) * 2; f32x4 rr[2][2][2];
              asm volatile("" ::: "memory");
#pragma unroll
              for (int mm = 0; mm < 2; ++mm) { const size_t off = (size_t)(ai * HALF + wr * 64 + (m0 + mm) * 16 + fr) * 1024 + col0;
#pragma unroll
                  for (int bj = 0; bj < 2; ++bj)
#pragma unroll
                      for (int n = 0; n < 2; ++n) rr[mm][bj][n] = __builtin_nontemporal_load((const f32x4*)(rb + off + bj * HALF + n * 16)); }
#pragma unroll
              for (int mm = 0; mm < 2; ++mm) { const int m = m0 + mm, rl = ai * HALF + wr * 64 + m * 16 + fr; float ss = 0.f;
#pragma unroll
                  for (int bj = 0; bj < 2; ++bj)
#pragma unroll
                      for (int n = 0; n < 2; ++n) { const f32x4 gv = *(const PG8_LAS f32x4*)(vec + cl + bj * HALF + n * 16); const f32x4 o = rr[mm][bj][n] + gv * acc[ai][bj][m][n];
                          acc[ai][bj][m][n] = o; ss += (o[0] * o[0] + o[1] * o[1]) + (o[2] * o[2] + o[3] * o[3]); }
                  ss += __shfl_xor(ss, 16); ss += __shfl_xor(ss, 32);
                  if (fq == 0) __hip_atomic_store(pb + (size_t)rl * 16, ss, __ATOMIC_RELAXED, __HIP_MEMORY_SCOPE_AGENT); } } }
        asm volatile("s_waitcnt vmcnt(0)" ::: "memory");
        unsigned* cw = cnt_ + 64 * u.pm;
        if (lane == 0) __hip_atomic_fetch_add(cw, 1u, __ATOMIC_RELAXED, __HIP_MEMORY_SCOPE_AGENT);
        if (wid == 0) { unsigned sp = 0;
            while ((unsigned)__builtin_amdgcn_readfirstlane(__hip_atomic_load(cw, __ATOMIC_RELAXED, __HIP_MEMORY_SCOPE_AGENT)) < 32u) { __builtin_amdgcn_s_sleep(2); if (++sp > (1u << 22)) break; } }
        asm volatile("s_waitcnt vmcnt(0) lgkmcnt(0)" ::: "memory"); __builtin_amdgcn_s_barrier(); asm volatile("" ::: "memory");
        if (tid < 256) { const unsigned long long* pp = (const unsigned long long*)(part_ + ((size_t)u.pm * BM + tid) * 16); float s = 0.f;
#pragma unroll
            for (int q = 0; q < 8; ++q) { const unsigned long long w = __hip_atomic_load(pp + q, __ATOMIC_RELAXED, __HIP_MEMORY_SCOPE_AGENT); s += __uint_as_float((unsigned)w) + __uint_as_float((unsigned)(w >> 32)); }
            tab_[tid] = 1.0f / sqrtf(s * (1.0f / 1024.0f) + 1e-6f); }
        asm volatile("s_waitcnt vmcnt(0) lgkmcnt(0)" ::: "memory"); __builtin_amdgcn_s_barrier(); asm volatile("" ::: "memory");
        { float* ob = xout_ + (size_t)u.pm * BM * 1024; bf16_t* hb = hn_ + (size_t)u.pm * BM * 1024;
#pragma unroll
          for (int ai = 0; ai < 2; ++ai)
#pragma unroll
            for (int m = 0; m < 4; ++m) { const int rl = ai * HALF + wr * 64 + m * 16 + fr; const size_t off = (size_t)rl * 1024 + col0; const float rs = tab_[rl];
#pragma unroll
                for (int bj = 0; bj < 2; ++bj)
#pragma unroll
                    for (int n = 0; n < 2; ++n) { const f32x4 gs = *(const PG8_LAS f32x4*)(vec + 256 + cl + bj * HALF + n * 16); const f32x4 o = acc[ai][bj][m][n];
                        if (FINAL) *(f32x4*)(ob + off + bj * HALF + n * 16) = o * rs * gs;
                        else { const f32x4 sh = *(const PG8_LAS f32x4*)(vec + 512 + cl + bj * HALF + n * 16);
                               *(f32x4*)(ob + off + bj * HALF + n * 16) = o; const f32x4 a = o * rs * gs + sh; u32x2 w; w.x = cvt_pk_bf16(a[0], a[1]); w.y = cvt_pk_bf16(a[2], a[3]); *(u32x2*)(hb + off + bj * HALF + n * 16) = w; } } }
        }
        asm volatile("s_waitcnt lgkmcnt(0)" ::: "memory"); __builtin_amdgcn_s_barrier(); asm volatile("" ::: "memory");
    }
};
struct EpiSplitRaw {
    static constexpr bool PERM = false, AFTER_DRAIN = false;
    float* part;
    __device__ __forceinline__ void operator()(const f32x4 (&acc)[2][2][4][2], const Unit& u, int wr, int wc, int fr, int fq) const {
        float* sb = part + (size_t)(u.kt0 / 12) * (2048 * 1024) + (size_t)(u.pm - 128) * BM * 1024; const int c0 = u.pn * BM + wc * 32 + 4 * fq;
#pragma unroll
        for (int ai = 0; ai < 2; ++ai)
#pragma unroll
            for (int m = 0; m < 4; ++m) { const size_t off = (size_t)(ai * HALF + wr * 64 + m * 16 + fr) * 1024 + c0;
#pragma unroll
                for (int bj = 0; bj < 2; ++bj)
#pragma unroll
                    for (int n = 0; n < 2; ++n) *(f32x4*)(sb + off + bj * HALF + n * 16) = acc[ai][bj][m][n]; }
    }
};
struct EpiInproj {
    static constexpr bool PERM = false, AFTER_DRAIN = false;
    bf16_t* HQ; bf16_t* KP; bf16_t* VP; float qs;
    __device__ __forceinline__ void operator()(const f32x4 (&acc)[2][2][4][2], const Unit& u, int wr, int wc, int fr, int fq) const {
        const int tt = u.pn >> 1; const bool lat = u.pm < 128; const bool rope = (tt < 2) && lat;
        const int row0 = u.pm * BM + wr * 64 + fr, cw = wc * 32 + 4 * fq;
        float fr4[4];
#pragma unroll
        for (int e = 0; e < 4; ++e) fr4[e] = __builtin_amdgcn_exp2f(-(float)(4 * fq + e) * (13.287712379549449f / 16.0f)) * 0.15915494309189535f;
        const float sc = (tt == 0) ? qs : 1.0f;
#pragma unroll
        for (int ai = 0; ai < 2; ++ai)
#pragma unroll
            for (int m = 0; m < 4; ++m) { const int row = row0 + ai * HALF + m * 16;
                bf16_t* p;
                if (tt == 0) p = HQ + (size_t)row * 512 + (u.pn & 1) * 256 + cw;
                else if (tt == 3) p = HQ + (size_t)34816 * 512 + ((size_t)((u.pn & 1) * 2) * 34816 + row) * 128 + cw;
                else { const int b = lat ? (row >> 12) : ((row - 32768) >> 8), kv = lat ? (row & 4095) : 4096 + ((row - 32768) & 255);
                       p = (tt == 1 ? KP : VP) + ((size_t)(b * 4 + (u.pn & 1) * 2) * 4352 + kv) * 128 + cw; }
                const size_t bjs = (tt == 0) ? (size_t)HALF : (tt == 3) ? (size_t)34816 * 128 : (size_t)4352 * 128;
                float cs[4], sn[4];
                if (rope) { const int t = row & 4095; const float pos = (float)((wc & 1) ? (t & 63) : (t >> 6));
#pragma unroll
                    for (int e = 0; e < 4; ++e) { const float rev = __builtin_amdgcn_fractf(pos * fr4[e]); cs[e] = __builtin_amdgcn_cosf(rev) * sc; sn[e] = __builtin_amdgcn_sinf(rev) * sc; } }
                else {
#pragma unroll
                    for (int e = 0; e < 4; ++e) { cs[e] = sc; sn[e] = 0.f; } }
#pragma unroll
                for (int bj = 0; bj < 2; ++bj) { const f32x4 a0 = acc[ai][bj][m][0], a1 = acc[ai][bj][m][1]; float o0[4], o1[4];
#pragma unroll
                    for (int e = 0; e < 4; ++e) { o0[e] = a0[e] * cs[e] - a1[e] * sn[e]; o1[e] = a1[e] * cs[e] + a0[e] * sn[e]; }
                    u32x2 w0, w1; w0.x = cvt_pk_bf16(o0[0], o0[1]); w0.y = cvt_pk_bf16(o0[2], o0[3]); w1.x = cvt_pk_bf16(o1[0], o1[1]); w1.y = cvt_pk_bf16(o1[2], o1[3]);
                    *(u32x2*)(p + bj * bjs) = w0; *(u32x2*)(p + bj * bjs + 16) = w1; }
            }
    }
};
template <class Epi, class Sched, bool ALIGN_EPI = false, bool SP2 = false>
__device__ __forceinline__ void gemm_phase(PG8_LAS unsigned char* lds, const Gemm g, const Sched& S, const Epi& E) {
    int tid_l = threadIdx.x; asm volatile("" : "+v"(tid_l));
    const int tid = tid_l, wid = __builtin_amdgcn_readfirstlane(tid >> 6), lane = tid & 63, wr = wid >> 2, wc = wid & 3, fr = lane & 15, fq = lane >> 4;
    const int K = g.K; int nt = 0;
    unsigned voffA[2], voffB[2];
#pragma unroll
    for (int i = 0; i < 2; ++i) { int R, C; stage_rc(tid * 16 + i * 8192, R, C); const int Rb = Epi::PERM ? ((R & ~31) + perm32(R & 31)) : R;
        voffA[i] = (unsigned)(R * K + C) * 2u; voffB[i] = (unsigned)(Rb * K + C) * 2u; }
    const size_t kstep = (size_t)(BK * 2);
    const size_t hstep = (size_t)HALF * K * 2;
    const size_t tstep = 2 * hstep;
    const unsigned ldsw = (unsigned)wid * 1024u;
    const int aoff = lds_byte(wr * 64 + fr, fq * 8), boff = lds_byte(wc * 32 + fr, fq * 8);
#define PG8_SA(b, h) (((b) * 2 + (h)) * HTB)
#define PG8_SB(b, h) ((4 + (b) * 2 + (h)) * HTB)
#define PG8_STAGE(bufoff, gbase, voff) do { _Pragma("unroll") for (int _i = 0; _i < 2; ++_i) \
        __builtin_amdgcn_global_load_lds((const unsigned*)((const char*)(gbase) + (voff)[_i]), (PG8_LAS unsigned*)(lds + (bufoff) + ldsw + _i * 8192), 16, 0, 0); } while (0)
#define PG8_LDA(dst, b, h) do { _Pragma("unroll") for (int m = 0; m < 4; ++m) _Pragma("unroll") for (int k = 0; k < 2; ++k) dst[m][k] = *(const PG8_LAS bf16x8*)(lds + PG8_SA(b, h) + aoff + m * 2048 + k * 1024); } while (0)
#define PG8_LDB(dst, b, h) do { _Pragma("unroll") for (int n = 0; n < 2; ++n) _Pragma("unroll") for (int k = 0; k < 2; ++k) dst[n][k] = *(const PG8_LAS bf16x8*)(lds + PG8_SB(b, h) + boff + n * 2048 + k * 1024); } while (0)
#define PG8_MMA(ai, bj, At, Bt) do { __builtin_amdgcn_s_setprio(1); _Pragma("unroll") for (int m = 0; m < 4; ++m) _Pragma("unroll") for (int n = 0; n < 2; ++n) _Pragma("unroll") for (int k = 0; k < 2; ++k) \
        acc[ai][bj][m][n] = __builtin_amdgcn_mfma_f32_16x16x32_bf16(Bt[n][k], At[m][k], acc[ai][bj][m][n], 0, 0, 0); __builtin_amdgcn_s_setprio(0); } while (0)
#define PG8_WAIT_V(n) asm volatile("s_waitcnt vmcnt(" #n ")" ::: "memory")
#define PG8_WAIT_L(n) asm volatile("s_waitcnt lgkmcnt(" #n ")" ::: "memory")
#define PG8_BAR __builtin_amdgcn_s_barrier()
#define PG8_SCHED __builtin_amdgcn_sched_barrier(0)
    Unit cur, nxt; int ui = 0;
    if (!S.next(0, cur)) return;
    f32x4 acc[2][2][4][2];
#pragma unroll
    for (int a = 0; a < 2; ++a)
#pragma unroll
        for (int b = 0; b < 2; ++b)
#pragma unroll
            for (int m = 0; m < 4; ++m)
#pragma unroll
                for (int n = 0; n < 2; ++n) acc[a][b][m][n] = (f32x4){0.f, 0.f, 0.f, 0.f};
    bf16x8 At[4][2], B0[2][2], B1[2][2];
    nt = cur.nk;
    const char* cA = (const char*)g.A + (size_t)cur.pm * tstep + (size_t)cur.kt0 * kstep; const char* cB = (const char*)g.Bt + (size_t)cur.pn * tstep + (size_t)cur.kt0 * kstep;
    S.a_ready(cur);
    if constexpr (SP2) {
        PG8_STAGE(PG8_SB(0, 0), cB, voffB); PG8_STAGE(PG8_SB(0, 1), cB + hstep, voffB); PG8_STAGE(PG8_SA(0, 0), cA, voffA); PG8_STAGE(PG8_SA(0, 1), cA + hstep, voffA);
        if (wr == 1) PG8_BAR;
        PG8_WAIT_V(2); PG8_BAR;
        PG8_STAGE(PG8_SB(1, 0), cB + kstep, voffB); PG8_STAGE(PG8_SA(1, 0), cA + kstep, voffA); PG8_STAGE(PG8_SB(1, 1), cB + hstep + kstep, voffB);
        PG8_WAIT_V(6); PG8_BAR;
    } else {
        PG8_STAGE(PG8_SB(0, 0), cB, voffB); PG8_STAGE(PG8_SA(0, 0), cA, voffA); PG8_STAGE(PG8_SB(0, 1), cB + hstep, voffB); PG8_STAGE(PG8_SA(0, 1), cA + hstep, voffA);
        if (wr == 1) PG8_BAR;
        PG8_WAIT_V(4); PG8_BAR;
        PG8_STAGE(PG8_SB(1, 0), cB + kstep, voffB); PG8_STAGE(PG8_SA(1, 0), cA + kstep, voffA); PG8_STAGE(PG8_SB(1, 1), cB + hstep + kstep, voffB);
        PG8_WAIT_V(6); PG8_BAR;
    }
    for (;;) {
        const bool has_next = S.next(ui + 1, nxt);
        const char* nA = has_next ? (const char*)g.A + (size_t)nxt.pm * tstep + (size_t)nxt.kt0 * kstep : cA; const char* nB = has_next ? (const char*)g.Bt + (size_t)nxt.pn * tstep + (size_t)nxt.kt0 * kstep : cB;
        for (int t = 0; t < nt; t += 2) {
            const bool last = (t == nt - 2);
            const char* a1 = cA + (size_t)(t + 1) * kstep;
            const char* a2 = last ? nA : cA + (size_t)(t + 2) * kstep; const char* b2 = last ? nB : cB + (size_t)(t + 2) * kstep;
            const char* a3 = a2 + kstep; const char* b3 = b2 + kstep;
            if (last && has_next) S.a_ready(nxt);
            if constexpr (SP2) {
            PG8_LDB(B0, 0, 0); PG8_LDB(B1, 0, 1); PG8_SCHED; PG8_LDA(At, 0, 0); PG8_STAGE(PG8_SA(1, 1), a1 + hstep, voffA);
            PG8_WAIT_V(8); PG8_WAIT_L(0); PG8_BAR; PG8_MMA(0, 0, At, B0); PG8_MMA(0, 1, At, B1); PG8_BAR; PG8_SCHED;
            PG8_LDA(At, 0, 1); PG8_STAGE(PG8_SB(0, 0), b2, voffB); PG8_STAGE(PG8_SB(0, 1), b2 + hstep, voffB); PG8_STAGE(PG8_SA(0, 0), a2, voffA);
            PG8_WAIT_V(8); PG8_WAIT_L(0); PG8_BAR; PG8_MMA(1, 0, At, B0); PG8_MMA(1, 1, At, B1); PG8_BAR; PG8_SCHED;
            PG8_LDB(B0, 1, 0); PG8_LDB(B1, 1, 1); PG8_SCHED; PG8_LDA(At, 1, 0); PG8_STAGE(PG8_SA(0, 1), a2 + hstep, voffA);
            PG8_WAIT_V(8); PG8_WAIT_L(0); PG8_BAR; PG8_MMA(0, 0, At, B0); PG8_MMA(0, 1, At, B1); PG8_BAR; PG8_SCHED;
            PG8_LDA(At, 1, 1); PG8_STAGE(PG8_SB(1, 0), b3, voffB); PG8_STAGE(PG8_SB(1, 1), b3 + hstep, voffB); PG8_STAGE(PG8_SA(1, 0), a3, voffA);
            PG8_WAIT_V(8); PG8_WAIT_L(0); PG8_BAR; PG8_MMA(1, 0, At, B0); PG8_MMA(1, 1, At, B1); PG8_BAR; PG8_SCHED;
            } else {
            PG8_LDB(B0, 0, 0); PG8_SCHED; PG8_LDA(At, 0, 0); PG8_STAGE(PG8_SA(1, 1), a1 + hstep, voffA);
            PG8_WAIT_L(8); PG8_BAR; PG8_WAIT_L(0); PG8_MMA(0, 0, At, B0); PG8_BAR; PG8_SCHED;
            PG8_LDB(B1, 0, 1); PG8_STAGE(PG8_SB(0, 0), b2, voffB);
            PG8_BAR; PG8_WAIT_L(0); PG8_MMA(0, 1, At, B1); PG8_BAR;
            PG8_LDA(At, 0, 1); PG8_STAGE(PG8_SA(0, 0), a2, voffA);
            PG8_BAR; PG8_WAIT_L(0); PG8_MMA(1, 0, At, B0); PG8_BAR; PG8_SCHED;
            PG8_STAGE(PG8_SB(0, 1), b2 + hstep, voffB);
            PG8_WAIT_V(6); PG8_BAR; PG8_MMA(1, 1, At, B1); PG8_BAR;
            PG8_LDB(B0, 1, 0); PG8_SCHED; PG8_LDA(At, 1, 0); PG8_STAGE(PG8_SA(0, 1), a2 + hstep, voffA);
            PG8_WAIT_L(8); PG8_BAR; PG8_WAIT_L(0); PG8_MMA(0, 0, At, B0); PG8_BAR; PG8_SCHED;
            PG8_LDB(B1, 1, 1); PG8_STAGE(PG8_SB(1, 0), b3, voffB);
            PG8_BAR; PG8_WAIT_L(0); PG8_MMA(0, 1, At, B1); PG8_BAR;
            PG8_LDA(At, 1, 1); PG8_STAGE(PG8_SA(1, 0), a3, voffA);
            PG8_BAR; PG8_WAIT_L(0); PG8_MMA(1, 0, At, B0); PG8_BAR; PG8_SCHED;
            PG8_STAGE(PG8_SB(1, 1), b3 + hstep, voffB);
            PG8_WAIT_V(6); PG8_BAR; PG8_MMA(1, 1, At, B1); PG8_BAR;
            }
        }
        if constexpr (ALIGN_EPI) { if (wr == 0) PG8_BAR; }
        if constexpr (!Epi::AFTER_DRAIN) { E(acc, cur, wr, wc, fr, fq); S.done(cur); }
        if (!has_next) break;
#pragma unroll
        for (int a = 0; a < 2; ++a)
#pragma unroll
            for (int b = 0; b < 2; ++b)
#pragma unroll
                for (int m = 0; m < 4; ++m)
#pragma unroll
                    for (int n = 0; n < 2; ++n) acc[a][b][m][n] = (f32x4){0.f, 0.f, 0.f, 0.f};
        cur = nxt; cA = nA; cB = nB; ++ui; nt = cur.nk;
        if constexpr (ALIGN_EPI) { if (wr == 1) PG8_BAR; }
    }
    PG8_WAIT_V(0);
    if constexpr (!ALIGN_EPI) { if (wr == 0) PG8_BAR; }
    PG8_BAR;
    if constexpr (Epi::AFTER_DRAIN) { E.fused(acc, cur, wr, wc, fr, fq, lds, wid, lane); S.done(cur); }
#undef PG8_SA
#undef PG8_SB
#undef PG8_STAGE
#undef PG8_LDA
#undef PG8_LDB
#undef PG8_MMA
#undef PG8_WAIT_V
#undef PG8_WAIT_L
#undef PG8_BAR
#undef PG8_SCHED
}
}

#include <hip/hip_cooperative_groups.h>
namespace cg = cooperative_groups;
#define LAS __attribute__((address_space(3)))
typedef unsigned short bf16;
typedef unsigned u32x4 __attribute__((ext_vector_type(4)));
typedef unsigned u32x2 __attribute__((ext_vector_type(2)));
typedef float f32x4 __attribute__((ext_vector_type(4)));
typedef float f32x16 __attribute__((ext_vector_type(16)));
typedef short bf16x8 __attribute__((ext_vector_type(8)));
typedef short s16x4 __attribute__((ext_vector_type(4)));

constexpr int D = 1024, NB = 8, SEQ = 4096, CTX = 256, DFF = 2816, NLAT = NB * SEQ  , NTOK = NLAT + NB * CTX  , INW = 2048, NMOD = 9 * D;
constexpr float EPS = 1e-6f, QSCALE = 0.125f * 1.4426950408889634f, LAM_INIT = 0.2f;
constexpr size_t MiB = 1u << 20;
constexpr size_t WS_BAR = 512 * 1024, WS_MOD = 0, WS_W1A = 1 * MiB, WS_W2A = 12 * MiB, WS_W1B = 18 * MiB, WS_W2B = 29 * MiB, WS_WIN = 35 * MiB, WS_WOUT = 39 * MiB, WS_WP = 41 * MiB,
                 WS_HN = 48 * MiB, WS_X1 = 116 * MiB, WS_BIG = 252 * MiB, WS_END = 440 * MiB;
static_assert(WS_HN + (size_t)NTOK * D * 2 <= WS_X1 && WS_X1 + (size_t)NTOK * D * 4 <= WS_BIG && WS_BIG + (size_t)NTOK * DFF * 2 <= WS_END, "ws map");
constexpr int LDS_BYTES = 147456, NWAVES = 8, NPHASE = 12;
#ifndef MK_N_LAUNCHES
#define MK_N_LAUNCHES 1
#endif

__device__ __forceinline__ unsigned f2bf(float f) { unsigned u = __builtin_bit_cast(unsigned, f); return (u + 0x7fffu + ((u >> 16) & 1u)) >> 16; }
__device__ __forceinline__ unsigned pk2(float lo, float hi) { return f2bf(lo) | (f2bf(hi) << 16); }
__device__ __forceinline__ unsigned cvtpk(float lo, float hi) { unsigned r; asm volatile("v_cvt_pk_bf16_f32 %0, %1, %2" : "=v"(r) : "v"(lo), "v"(hi)); return r; }
__device__ __forceinline__ float bflo(unsigned w) { return __builtin_bit_cast(float, w << 16); }
__device__ __forceinline__ float bfhi(unsigned w) { return __builtin_bit_cast(float, w & 0xffff0000u); }
__device__ __forceinline__ float wave_sum(float v) {
#pragma unroll
    for (int o = 1; o < 64; o <<= 1) v += __shfl_xor(v, o);
    return v;
}
__device__ __forceinline__ int crow(int r, int hi) { return (r & 3) + 8 * (r >> 2) + 4 * hi; }

__device__ __forceinline__ void adaln_unit(LAS unsigned char* lds, int unit, const float* c, const float* c_ctx, const float* w_mod, const float* b_mod, float* mod, int tid) {
    LAS float* scond = (LAS float*)lds;
    LAS float* part = (LAS float*)(lds + 36864);
    for (int i = tid; i < 9 * D; i += 512) { const int r = i >> 10, k = i & 1023; const float v = (r < 8) ? c[r * D + k] : c_ctx[k]; scond[i] = v / (1.0f + __expf(-v)); }
    __syncthreads();
    const int cgp = tid & 15, ks = tid >> 4;
    f32x4 acc[9];
#pragma unroll
    for (int r = 0; r < 9; ++r) acc[r] = (f32x4){0.f, 0.f, 0.f, 0.f};
    const float* wp = w_mod + (size_t)(32 * ks) * NMOD + 64 * unit + 4 * cgp;
#pragma unroll 8
    for (int kk = 0; kk < 32; ++kk) { const f32x4 w = *(const f32x4*)(wp + (size_t)kk * NMOD);
#pragma unroll
        for (int r = 0; r < 9; ++r) acc[r] += w * scond[r * D + 32 * ks + kk]; }
#pragma unroll
    for (int r = 0; r < 9; ++r) *(LAS f32x4*)(part + (ks * 9 + r) * 64 + 4 * cgp) = acc[r];
    __syncthreads();
    for (int o = tid; o < 9 * 64; o += 512) { const int r = o >> 6, cc = o & 63; float s = 0.f;
#pragma unroll 8
        for (int k2 = 0; k2 < 32; ++k2) s += part[(k2 * 9 + r) * 64 + cc];
        mod[(size_t)r * NMOD + 64 * unit + cc] = s + b_mod[64 * unit + cc]; }
    __syncthreads();
}
__device__ __forceinline__ void transpose_item(const float* W, int ldw, bf16* WT, int ldt, int k0, int n0, int drow0, LAS float* scr, int lane) {
#pragma unroll 8
    for (int i = 0; i < 32; ++i) { const int kk = 2 * i + (lane >> 5); scr[kk * 33 + (lane & 31)] = W[(size_t)(k0 + kk) * ldw + n0 + (lane & 31)]; }
    asm volatile("s_waitcnt lgkmcnt(0)" ::: "memory");
    const int c = lane & 7;
#pragma unroll
    for (int j = 0; j < 4; ++j) { const int n = (lane >> 3) + 8 * j; const LAS float* s = scr + (8 * c) * 33 + n;
        u32x4 o; o.x = pk2(s[0 * 33], s[1 * 33]); o.y = pk2(s[2 * 33], s[3 * 33]); o.z = pk2(s[4 * 33], s[5 * 33]); o.w = pk2(s[6 * 33], s[7 * 33]);
        *(u32x4*)(WT + (size_t)(drow0 + n) * ldt + k0 + 8 * c) = o; }
    asm volatile("s_waitcnt lgkmcnt(0)" ::: "memory");
}
__device__ __forceinline__ void transpose_mat_item(const float* W, int K, int N, bf16* WT, bool swiglu, int item, LAS float* scr, int lane) {
    const int nblk = N / 32, kb = item / nblk, nb = item % nblk, n0 = 32 * nb; int drow0 = n0;
    if (swiglu) { const int half = N / 2; const int j = (n0 < half) ? n0 : n0 - half; drow0 = (j >> 7) * 256 + ((n0 < half) ? 0 : 128) + (j & 127); }
    transpose_item(W, N, WT, K, 64 * kb, n0, drow0, scr, lane);
}

__device__ __forceinline__ void norm_pass(const float* lat, const float* ctxp, int nrows, const float* g, const float* mod, int sh_i, int sc_i, bf16* dst, float* dstf, int wave, int lane, const float* part = nullptr, const float* pgate = nullptr, int row_begin = 0) {
    const int gw = blockIdx.x * NWAVES + wave, NGW = gridDim.x * NWAVES, nch = nrows >> 2;
    for (int ch = gw + (row_begin >> 2); ch < nch; ch += NGW) {
        const int row0 = ch * 4; const bool isl = row0 < NLAT; const int rix = isl ? (row0 >> 12) : 8;
        const float* src = isl ? lat + (size_t)row0 * D : ctxp + (size_t)(row0 - NLAT) * D;
        f32x4 gs[4], sh[4];
#pragma unroll
        for (int j = 0; j < 4; ++j) { const int col = 4 * lane + 256 * j; gs[j] = *(const f32x4*)(g + col);
            if (mod) { gs[j] = gs[j] * (*(const f32x4*)(mod + (size_t)rix * NMOD + sc_i * D + col) + 1.0f); sh[j] = *(const f32x4*)(mod + (size_t)rix * NMOD + sh_i * D + col); }
            else sh[j] = (f32x4){0.f, 0.f, 0.f, 0.f}; }
#pragma unroll
        for (int rr = 0; rr < 4; ++rr) {
            f32x4 v[4]; float ss = 0.f;
#pragma unroll
            for (int j = 0; j < 4; ++j) { v[j] = __builtin_nontemporal_load((const f32x4*)(src + (size_t)rr * D + 4 * lane + 256 * j));
                if (part && !isl) { const float* pp = part + (size_t)(row0 - NLAT + rr) * D + 4 * lane + 256 * j; const size_t ps = (size_t)2048 * 1024;
                    const f32x4 sp = (*(const f32x4*)pp + *(const f32x4*)(pp + ps)) + (*(const f32x4*)(pp + 2 * ps) + *(const f32x4*)(pp + 3 * ps));
                    v[j] = v[j] + sp * (*(const f32x4*)(pgate + 4 * lane + 256 * j) * 0.5f); }
                ss += (v[j].x * v[j].x + v[j].y * v[j].y) + (v[j].z * v[j].z + v[j].w * v[j].w); }
            const float rstd = 1.0f / sqrtf(wave_sum(ss) * (1.0f / D) + EPS);
#pragma unroll
            for (int j = 0; j < 4; ++j) { const f32x4 o = v[j] * rstd * gs[j] + sh[j]; const size_t off = (size_t)(row0 + rr) * D + 4 * lane + 256 * j;
                if (dstf) __builtin_nontemporal_store(o, (f32x4*)(dstf + off));
                else { u32x2 w; w.x = pk2(o.x, o.y); w.y = pk2(o.z, o.w); *(u32x2*)(dst + off) = w; } }
        }
    }
}

constexpr int PU_STRIDE = 320, PU_ROWS = 144, PO_OFF = PU_ROWS * PU_STRIDE  , PW_OFF = PO_OFF + 128 * 272  ;
__device__ __forceinline__ bf16x8 pfrag(const LAS unsigned char* p) { const s16x4 vl = __builtin_bit_cast(s16x4, __builtin_amdgcn_ds_read_tr16_b64_v4i16((LAS s16x4*)p)), vh = __builtin_bit_cast(s16x4, __builtin_amdgcn_ds_read_tr16_b64_v4i16((LAS s16x4*)(p + 8 * PU_STRIDE)));
    return (bf16x8){vl[0], vl[1], vl[2], vl[3], vh[0], vh[1], vh[2], vh[3]}; }
__device__ __forceinline__ void pool_load(int rb, int gi, const bf16* HX, const bf16* WPt, u32x4 (&v)[5], u32x4 (&wv)[4], int tid) {
    const int b = rb >> 5, t0 = (rb & 31) * 128;
#pragma unroll
    for (int k = 0; k < 5; ++k) { const int cidx = tid + 512 * k, i = cidx >> 4, ch = cidx & 15, t = t0 - 8 + i; v[k] = (u32x4){0u, 0u, 0u, 0u};
        if (cidx < PU_ROWS * 16 && t >= 0 && t < SEQ) v[k] = *(const u32x4*)(HX + (size_t)NTOK * 512 + ((size_t)gi * NTOK + (size_t)b * SEQ + t) * 128 + ch * 8); }
#pragma unroll
    for (int k = 0; k < 4; ++k) { const int cidx = tid + 512 * k; wv[k] = *(const u32x4*)(WPt + (size_t)gi * 128 * 128 + cidx * 8); }
}
__device__ __forceinline__ void pool_stage(LAS unsigned char* lds, const u32x4 (&v)[5], const u32x4 (&wv)[4], int tid) {
#pragma unroll
    for (int k = 0; k < 5; ++k) { const int cidx = tid + 512 * k, i = cidx >> 4, ch = cidx & 15; if (cidx < PU_ROWS * 16) *(LAS u32x4*)(lds + i * PU_STRIDE + ch * 16) = v[k]; }
#pragma unroll
    for (int k = 0; k < 4; ++k) { const int cidx = tid + 512 * k, n = cidx >> 4, ch = cidx & 15; *(LAS u32x4*)(lds + PW_OFF + n * 272 + ch * 16) = wv[k]; }
}
__device__ __forceinline__ void pool_compute(LAS unsigned char* lds, int rb, int gi, const float* pool_scale, bf16* MIX, int tid, int wave, int lane) {
    const int b = rb >> 5, t0 = (rb & 31) * 128, lo = 1 << gi;
    const int r32 = lane & 31, hi = lane >> 5, tb = wave & 3, half = wave >> 2;
    f32x16 acc[4]; acc[0] = f32x16{}; acc[1] = f32x16{}; acc[2] = f32x16{}; acc[3] = f32x16{};
    { const LAS unsigned char* ub = lds + (4 * hi + ((lane & 15) >> 2)) * PU_STRIDE + (16 * ((lane >> 4) & 1) + 4 * (lane & 3)) * 2;
#pragma unroll
      for (int ksl = 0; ksl < 3; ++ksl) { const int ks = 2 * tb + ksl;
          u32x4 bw;
#pragma unroll
          for (int jj = 0; jj < 4; ++jj) { const int j0 = 2 * jj, j1 = 2 * jj + 1;
              const int d0 = 16 * ks + 4 * hi + (j0 & 3) + 8 * (j0 >> 2) - 8 - (32 * tb + r32), d1 = 16 * ks + 4 * hi + (j1 & 3) + 8 * (j1 >> 2) - 8 - (32 * tb + r32);
              bw[jj] = ((d0 >= -lo && d0 < lo) ? 0x3F80u : 0u) | ((d1 >= -lo && d1 < lo) ? 0x3F800000u : 0u); }
          const bf16x8 bfr = __builtin_bit_cast(bf16x8, bw);
#pragma unroll
          for (int cb = 0; cb < 4; ++cb) acc[cb] = __builtin_amdgcn_mfma_f32_32x32x16_bf16(pfrag(ub + ks * 16 * PU_STRIDE + cb * 64), bfr, acc[cb], 0, 0, 0); } }
    bf16x8 dfr[8];
    { const int t = t0 + 32 * tb + r32; const int st = (t - lo > 0) ? t - lo : 0, en = (t + lo - 1 < SEQ - 1) ? t + lo - 1 : SEQ - 1; const float inv = 1.0f / (float)(en - st + 1);
      const LAS unsigned char* own = lds + (32 * tb + r32 + 8) * PU_STRIDE + 8 * hi;
#pragma unroll
      for (int cb = 0; cb < 4; ++cb) { u32x2 dw[4];
#pragma unroll
          for (int g4 = 0; g4 < 4; ++g4) { const u32x2 o2 = *(const LAS u32x2*)(own + (32 * cb + 8 * g4) * 2);
              dw[g4].x = cvtpk(acc[cb][4 * g4] * inv - bflo(o2.x), acc[cb][4 * g4 + 1] * inv - bfhi(o2.x)); dw[g4].y = cvtpk(acc[cb][4 * g4 + 2] * inv - bflo(o2.y), acc[cb][4 * g4 + 3] * inv - bfhi(o2.y)); }
          dfr[2 * cb] = __builtin_bit_cast(bf16x8, (u32x4){dw[0].x, dw[0].y, dw[1].x, dw[1].y}); dfr[2 * cb + 1] = __builtin_bit_cast(bf16x8, (u32x4){dw[2].x, dw[2].y, dw[3].x, dw[3].y}); } }
    f32x16 out[2]; out[0] = f32x16{}; out[1] = f32x16{};
#pragma unroll
    for (int nbl = 0; nbl < 2; ++nbl) { const LAS unsigned char* wrow = lds + PW_OFF + (32 * (2 * half + nbl) + r32) * 272 + 8 * hi;
#pragma unroll
        for (int kq = 0; kq < 8; ++kq) { const u32x2 a0 = *(const LAS u32x2*)(wrow + 32 * kq), a1 = *(const LAS u32x2*)(wrow + 32 * kq + 16);
            out[nbl] = __builtin_amdgcn_mfma_f32_32x32x16_bf16(__builtin_bit_cast(bf16x8, (u32x4){a0.x, a0.y, a1.x, a1.y}), dfr[kq], out[nbl], 0, 0, 0); } }
    { LAS unsigned char* ot = lds + PO_OFF + (32 * tb + r32) * 272;
#pragma unroll
      for (int nbl = 0; nbl < 2; ++nbl)
#pragma unroll
        for (int rq = 0; rq < 4; ++rq) { const int n0 = 32 * (2 * half + nbl) + 8 * rq + 4 * hi; const f32x4 ps = *(const f32x4*)(pool_scale + gi * 128 + n0);
            u32x2 w; w.x = cvtpk(out[nbl][4 * rq] * ps.x, out[nbl][4 * rq + 1] * ps.y); w.y = cvtpk(out[nbl][4 * rq + 2] * ps.z, out[nbl][4 * rq + 3] * ps.w);
            *(LAS u32x2*)(ot + n0 * 2) = w; } }
    __syncthreads();
#pragma unroll
    for (int k = 0; k < 4; ++k) { const int cidx = tid + 512 * k, row = cidx >> 4, ch = cidx & 15;
        *(u32x4*)(MIX + ((size_t)b * SEQ + t0 + row) * D + 512 + gi * 128 + ch * 8) = *(const LAS u32x4*)(lds + PO_OFF + row * 272 + ch * 16); }
}

constexpr int AK_STRIDE = 144, AV_STRIDE = 320, AK_BYTES = 64 * AK_STRIDE, AKS = 2 * AK_BYTES  , AVS = 64 * AV_STRIDE  , AV_BASE = 3 * AKS;
#define SBAR() __builtin_amdgcn_sched_barrier(0)
typedef float f32x2_t __attribute__((ext_vector_type(2))); typedef __bf16 bf16x2_t __attribute__((ext_vector_type(2)));
__device__ __forceinline__ unsigned cvtpk_s(float lo, float hi) { f32x2_t v = {lo, hi}; bf16x2_t bb = __builtin_convertvector(v, bf16x2_t); return __builtin_bit_cast(unsigned, bb); }
__device__ __forceinline__ s16x4 vtr(const LAS unsigned char* p) { return __builtin_bit_cast(s16x4, __builtin_amdgcn_ds_read_tr16_b64_v4i16((LAS s16x4*)p)); }
__device__ __forceinline__ bf16x8 vfrag(const LAS unsigned char* p) { const s16x4 vl = vtr(p), vh = vtr(p + 8 * AV_STRIDE); return (bf16x8){vl[0], vl[1], vl[2], vl[3], vh[0], vh[1], vh[2], vh[3]}; }
__device__ __forceinline__ void glds16(const void* gsrc, unsigned lds_dst) { unsigned keep;
    asm volatile("s_mov_b32 %0, m0\n\ts_mov_b32 m0, %2\n\ts_nop 0\n\tglobal_load_lds_dwordx4 %1, off\n\ts_mov_b32 m0, %0" : "=&s"(keep) : "v"(gsrc), "s"(lds_dst) : "memory"); }
__device__ __forceinline__ float max3f(float a, float b, float c) { float r; asm("v_max3_f32 %0, %1, %2, %3" : "=v"(r) : "v"(a), "v"(b), "v"(c)); return r; }
#define WAIT_BAR0() asm volatile("s_waitcnt vmcnt(0) lgkmcnt(0)\n\ts_barrier" ::: "memory")
#define WAIT_BAR5() asm volatile("s_waitcnt vmcnt(5) lgkmcnt(0)\n\ts_barrier" ::: "memory")
template <int MODE> __device__ __forceinline__ void attn_unit(LAS unsigned char* lds, int b, int h, int qb, const bf16* HQ, const bf16* KP, const bf16* VP, bf16* MIX, const float* g_sub, float lam, int tid, int wave, int lane) {
    const int r32 = lane & 31, hi = lane >> 5, map = wave >> 2, qw = wave & 3;
    const size_t qrow = (size_t)b * SEQ + qb * 128 + qw * 32 + r32;
    bf16x8 qf[4];
#pragma unroll
    for (int d0 = 0; d0 < 4; ++d0) qf[d0] = *(const bf16x8*)(HQ + qrow * 512 + h * 128 + map * 64 + d0 * 16 + hi * 8);
    unsigned soff[5], ldst[5]; bool isv[5], valid[5];
#pragma unroll
    for (int i = 0; i < 5; ++i) { const int bid = wave + 8 * i; valid[i] = bid < 38; isv[i] = bid >= 18;
        if (bid < 18) { const int km = bid / 9, j = bid % 9, p = 64 * j + lane, row = p / 9; int ch = p % 9; if (ch == 8) ch = 0;
            soff[i] = (unsigned)(row * 128 + km * 64 + ch * 8) * 2u; ldst[i] = km * AK_BYTES + j * 1024; }
        else { const int j = bid - 18, p = 64 * j + lane, row = p / 20; int ch = p % 20; if (ch >= 16) ch = 0;
            soff[i] = (unsigned)(row * 128 + ch * 8) * 2u; ldst[i] = j * 1024; } }
    if (!valid[4]) { soff[4] = soff[0]; ldst[4] = ldst[0]; isv[4] = isv[0]; valid[4] = true; }
    const unsigned lds0 = (unsigned)(uintptr_t)lds;
    const char* kbase = (const char*)(KP + (size_t)(b * 4 + h) * 4352 * 128); const char* vbase = (const char*)(VP + (size_t)(b * 4 + h) * 4352 * 128);
#define DMA_I(i, tk, sk, tv, sv, dok, dov) do { if (!(MODE & 2) && (isv[i] ? (dov) : (dok))) { const int tt_ = isv[i] ? (tv) : (tk); \
        glds16((isv[i] ? vbase : kbase) + (size_t)tt_ * 16384 + soff[i], (unsigned)__builtin_amdgcn_readfirstlane(lds0 + (isv[i] ? AV_BASE + (sv) * AVS : (sk) * AKS) + ldst[i])); } } while (0)
#define DMA_KV(tk, sk, tv, sv, dok, dov) do { DMA_I(0, tk, sk, tv, sv, dok, dov); DMA_I(1, tk, sk, tv, sv, dok, dov); DMA_I(2, tk, sk, tv, sv, dok, dov); DMA_I(3, tk, sk, tv, sv, dok, dov); DMA_I(4, tk, sk, tv, sv, dok, dov); } while (0)
    constexpr int NT = (SEQ + CTX) / 64;
    DMA_KV(0, 0, 0, 0, true, false);
    DMA_KV(1, 1, 0, 0, true, true);
    WAIT_BAR5();
    f32x16 o[4]; o[0] = f32x16{}; o[1] = f32x16{}; o[2] = f32x16{}; o[3] = f32x16{};
    const f32x16 zero16 = f32x16{};
    float mrun = -INFINITY, lrun = 0.f;
    const unsigned koff = map * AK_BYTES + r32 * AK_STRIDE + hi * 16;
    const unsigned voff = AV_BASE + (4 * hi + ((lane & 15) >> 2)) * AV_STRIDE + (16 * ((lane >> 4) & 1) + 4 * (lane & 3)) * 2;
    u32x4 pw[4];
    f32x16 X0, X1;
#define KFR(i) (*(const LAS bf16x8*)(kb_ + (1 - ((i) >> 2)) * 32 * AK_STRIDE + ((i) & 3) * 32))
#define VFR(i) vfrag(vb_ + ((i) >> 2) * 16 * AV_STRIDE + ((i) & 3) * 64)
#define GAPA(i, HASP) do { if ((i) + 3 < 8) kr[((i) + 3) & 3] = KFR((i) + 3); \
        if ((i) < 4) { X1 = __builtin_amdgcn_mfma_f32_32x32x16_bf16(kr[(i) & 3], qf[(i) & 3], ((i) & 3) ? X1 : zero16, 0, 0, 0); \
            if (HASP) { sacc += (X0[(4 * (i)) & 15] + X0[(4 * (i) + 1) & 15]) + (X0[(4 * (i) + 2) & 15] + X0[(4 * (i) + 3) & 15]); \
                pw[((i) >> 1) & 1][((i) & 1) * 2] = cvtpk_s(X0[(4 * (i)) & 15], X0[(4 * (i) + 1) & 15]); pw[((i) >> 1) & 1][((i) & 1) * 2 + 1] = cvtpk_s(X0[(4 * (i) + 2) & 15], X0[(4 * (i) + 3) & 15]); asm volatile("" : "+v"(sacc)); } } \
        else X0 = __builtin_amdgcn_mfma_f32_32x32x16_bf16(kr[(i) & 3], qf[(i) & 3], ((i) & 3) ? X0 : zero16, 0, 0, 0); \
        SBAR(); } while (0)
#define EXC_(v) do { if (MODE & 1) break; if ((v) < 16) X0[(v) & 15] = __builtin_amdgcn_exp2f(X0[(v) & 15] - mrun); else X1[(v) & 15] = __builtin_amdgcn_exp2f(X1[(v) & 15] - mrun); } while (0)
#define GAPB(i, HASP) do { if ((HASP) && !(MODE & 4)) { if ((i) + 3 < 16) vr[((i) + 3) & 3] = VFR((i) + 3); \
            o[(i) & 3] = __builtin_amdgcn_mfma_f32_32x32x16_bf16(vr[(i) & 3], __builtin_bit_cast(bf16x8, pw[(i) >> 2]), o[(i) & 3], 0, 0, 0); } \
        EXC_(2 * (i)); EXC_(2 * (i) + 1); if ((i) < 8) asm volatile("" : "+v"(X0)); else asm volatile("" : "+v"(X1)); SBAR(); } while (0)
#define STEP(t, s0, HASP, DOK, DOV, WAITB) do { \
        const int s1_ = ((s0) == 2) ? 0 : (s0) + 1, s2_ = ((s0) == 0) ? 2 : (s0) - 1;     \
        const LAS unsigned char* kb_ = lds + (s0) * AKS + koff; const LAS unsigned char* vb_ = lds + s2_ * AVS + voff; \
        DMA_KV((t) + 2, s2_, (t) + 1, s1_, DOK, DOV); \
        bf16x8 kr[4]; kr[0] = KFR(0); kr[1] = KFR(1); kr[2] = KFR(2); float sacc = 0.f; SBAR(); \
        GAPA(0, HASP); GAPA(1, HASP); GAPA(2, HASP); GAPA(3, HASP); GAPA(4, HASP); GAPA(5, HASP); GAPA(6, HASP); GAPA(7, HASP); \
        lrun += sacc; \
        bf16x8 vr[4]; if ((HASP) && !(MODE & 4)) { vr[0] = VFR(0); vr[1] = VFR(1); vr[2] = VFR(2); } \
        float mx = fmaxf(X0[0], X1[0]); \
        if (!(MODE & 1)) { _Pragma("unroll") for (int r_ = 1; r_ < 16; ++r_) mx = max3f(mx, X0[r_], X1[r_]); } \
        { auto rr_ = __builtin_amdgcn_permlane32_swap(__float_as_uint(mx), __float_as_uint(mx), false, false); mx = max3f(mx, __uint_as_float(rr_[0]), __uint_as_float(rr_[1])); } \
        const bool resc = __any(mx > mrun); const float mn = max3f(mrun, mrun, mx), fsc = __builtin_amdgcn_exp2f(mrun - mn); lrun *= fsc; mrun = mn;     \
        SBAR(); \
        GAPB(0, HASP); GAPB(1, HASP); GAPB(2, HASP); GAPB(3, HASP); GAPB(4, HASP); GAPB(5, HASP); GAPB(6, HASP); GAPB(7, HASP); \
        GAPB(8, HASP); GAPB(9, HASP); GAPB(10, HASP); GAPB(11, HASP); GAPB(12, HASP); GAPB(13, HASP); GAPB(14, HASP); GAPB(15, HASP); \
        if (resc) { _Pragma("unroll") for (int db_ = 0; db_ < 4; ++db_) o[db_] = o[db_] * fsc; } \
        { float st_ = 0.f; _Pragma("unroll") for (int r_ = 0; r_ < 16; ++r_) st_ += X1[r_]; lrun += st_; \
          pw[2] = (u32x4){cvtpk_s(X1[0], X1[1]), cvtpk_s(X1[2], X1[3]), cvtpk_s(X1[4], X1[5]), cvtpk_s(X1[6], X1[7])}; \
          pw[3] = (u32x4){cvtpk_s(X1[8], X1[9]), cvtpk_s(X1[10], X1[11]), cvtpk_s(X1[12], X1[13]), cvtpk_s(X1[14], X1[15])}; } \
        WAITB(); } while (0)
    STEP(0, 0, false, true, true, WAIT_BAR5);
    { int s0 = 1;
      for (int t = 1; t < NT - 2; ++t) { STEP(t, s0, true, true, true, WAIT_BAR5); s0 = (s0 == 2) ? 0 : s0 + 1; } }
    STEP(NT - 2, (NT - 2) % 3, true, false, true, WAIT_BAR0);
    STEP(NT - 1, (NT - 1) % 3, true, false, false, WAIT_BAR0);
    { float sacc = 0.f;
#pragma unroll
      for (int r = 0; r < 16; ++r) sacc += X0[r];
      lrun += sacc;
      pw[0] = (u32x4){cvtpk_s(X0[0], X0[1]), cvtpk_s(X0[2], X0[3]), cvtpk_s(X0[4], X0[5]), cvtpk_s(X0[6], X0[7])};
      pw[1] = (u32x4){cvtpk_s(X0[8], X0[9]), cvtpk_s(X0[10], X0[11]), cvtpk_s(X0[12], X0[13]), cvtpk_s(X0[14], X0[15])};
      const LAS unsigned char* vb_ = lds + ((NT - 1) % 3) * AVS + voff;
#pragma unroll
      for (int i = 0; i < 16; ++i) o[i & 3] = __builtin_amdgcn_mfma_f32_32x32x16_bf16(VFR(i), __builtin_bit_cast(bf16x8, pw[i >> 2]), o[i & 3], 0, 0, 0);
    }
    __syncthreads();
#undef DMA_I
#undef DMA_KV
#undef KFR
#undef VFR
#undef GAPA
#undef EXC_
#undef GAPB
#undef STEP
    lrun += __shfl_xor(lrun, 32);
    const float rl = 1.0f / lrun;
    LAS float* ex = (LAS float*)lds + qw * 4096;
    if (map == 1) {
#pragma unroll
        for (int db = 0; db < 4; ++db)
#pragma unroll
            for (int r = 0; r < 16; ++r) ex[(db * 16 + r) * 64 + lane] = o[db][r] * rl;
    }
    __syncthreads();
    if (map == 0) {
        float ss = 0.f;
#pragma unroll
        for (int db = 0; db < 4; ++db)
#pragma unroll
            for (int r = 0; r < 16; ++r) { const float v = o[db][r] * rl - lam * ex[(db * 16 + r) * 64 + lane]; o[db][r] = v; ss += v * v; }
        ss += __shfl_xor(ss, 32);
        const float rstd = (1.0f - LAM_INIT) / sqrtf(ss * (1.0f / 128.0f) + EPS);
        bf16* op = MIX + qrow * D + h * 128;
#pragma unroll
        for (int db = 0; db < 4; ++db)
#pragma unroll
            for (int rq = 0; rq < 4; ++rq) { const int d0 = 32 * db + 8 * rq + 4 * hi; const f32x4 gsv = *(const LAS f32x4*)(lds + 131072 + 2048 + d0 * 4);
                u32x2 w; w.x = cvtpk(o[db][4 * rq] * rstd * gsv.x, o[db][4 * rq + 1] * rstd * gsv.y); w.y = cvtpk(o[db][4 * rq + 2] * rstd * gsv.z, o[db][4 * rq + 3] * rstd * gsv.w);
                *(u32x2*)(op + d0) = w; }
    }
    __syncthreads();
}
#undef SBAR

#define XB_TMO      128
#define XB_XCNT(j)  (256  + 64 * (j))
#define XB_XSUB(j)  (1280 + 64 * (j))
#define XB_XGEN(j)  (2304 + 64 * (j))
#define XB_TOP      3328
#define XB_TOPGEN   3392
#define XCD_BAR_WORDS 3456
#define XB_SPIN_CAP (1u << 18)

__device__ __forceinline__ unsigned xb_ld(unsigned* p)              { return __hip_atomic_load(p, __ATOMIC_RELAXED, __HIP_MEMORY_SCOPE_AGENT); }
__device__ __forceinline__ unsigned xb_add(unsigned* p, unsigned v) { return __hip_atomic_fetch_add(p, v, __ATOMIC_RELAXED, __HIP_MEMORY_SCOPE_AGENT); }
__device__ __forceinline__ unsigned xb_xcc_id() { return (unsigned)__builtin_amdgcn_s_getreg((3 << 11) | 20) & 0xFu; }
#define XB_SPIN(cond, bar) do { unsigned _sp = 0; while (cond) { __builtin_amdgcn_s_sleep(1); \
    if ((++_sp & 255u) == 0u) { if (xb_ld(&(bar)[XB_TMO])) break; if (_sp > XB_SPIN_CAP) { atomicAdd(&(bar)[XB_TMO], 1u); break; } } } } while (0)

struct XcdBarrier {
    unsigned* bar; unsigned x;
    volatile LAS unsigned* st;
};

__device__ __forceinline__ XcdBarrier xcd_barrier_post(unsigned* bar, volatile LAS unsigned* st) {
    XcdBarrier b; b.bar = bar; b.x = xb_xcc_id(); b.st = st;
    if (threadIdx.x == 0) (void)xb_add(&bar[XB_XCNT(b.x)], 1u);
    return b;
}
__device__ __forceinline__ void xcd_barrier_complete(unsigned* bar, unsigned x, unsigned& nloc, unsigned& nx) {
    const unsigned G = gridDim.x * gridDim.y * gridDim.z;
    unsigned sum, cnt, mine, sp = 0u;
    for (;;) {
        sum = 0u; cnt = 0u; mine = 0u;
#pragma unroll
        for (unsigned j = 0; j < 16; ++j) { const unsigned c = xb_ld(&bar[XB_XCNT(j)]); sum += c; cnt += (c > 0u) ? 1u : 0u; mine = (j == x) ? c : mine; }
        if (sum == G) break;
        __builtin_amdgcn_s_sleep(1);
        if ((++sp & 255u) == 0u) { if (xb_ld(&bar[XB_TMO])) break; if (sp > XB_SPIN_CAP) { atomicAdd(&bar[XB_TMO], 1u); break; } }
    }
    nloc = mine > 0u ? mine : 1u; nx = cnt > 0u ? cnt : 1u;
}

__device__ __forceinline__ void xcd_barrier(const XcdBarrier& b) {
    asm volatile("s_waitcnt vmcnt(0)" ::: "memory");
    __syncthreads();
    if (threadIdx.x == 0) {
        unsigned* bar = b.bar;
        __builtin_amdgcn_s_waitcnt(0);
        unsigned nloc = b.st[0], nx = b.st[1];
        if (nloc == 0u) { xcd_barrier_complete(bar, b.x, nloc, nx); b.st[0] = nloc; b.st[1] = nx; }
        const unsigned old = xb_add(&bar[XB_XSUB(b.x)], 1u);
        const unsigned gen = old / nloc;
        if (old + 1u == (gen + 1u) * nloc) {
            __builtin_amdgcn_fence(__ATOMIC_RELEASE, "agent");
            asm volatile("s_waitcnt vmcnt(0)" ::: "memory");
            const unsigned og = xb_add(&bar[XB_TOP], 1u);
            const unsigned tg = og / nx;
            if (og + 1u == (tg + 1u) * nx) xb_add(&bar[XB_TOPGEN], 1u);
            else XB_SPIN(xb_ld(&bar[XB_TOPGEN]) == tg, bar);
            __builtin_amdgcn_fence(__ATOMIC_ACQUIRE, "agent");
            xb_add(&bar[XB_XGEN(b.x)], 1u);
            asm volatile("s_waitcnt vmcnt(0)" ::: "memory");
        } else {
            XB_SPIN(xb_ld(&bar[XB_XGEN(b.x)]) == gen, bar);
            __builtin_amdgcn_fence(__ATOMIC_ACQUIRE, "agent");
            asm volatile("s_waitcnt vmcnt(0)" ::: "memory");
        }
    }
    __syncthreads();
}

struct Args { const float* in[23]; float* out; unsigned char* ws; int ph_lo, ph_hi; };
__global__ void __launch_bounds__(NWAVES * 64, 2) mk_fwd(Args a) {
    extern __shared__ __attribute__((aligned(16))) unsigned char lds_raw[];
    LAS unsigned char* lds = (LAS unsigned char*)lds_raw;
    const int tid = threadIdx.x, lane = tid & 63, wave = __builtin_amdgcn_readfirstlane(tid >> 6), G = gridDim.x, bx = blockIdx.x;
    unsigned char* ws = a.ws;
    const float *x = a.in[0], *c = a.in[1], *ctx = a.in[2], *c_ctx = a.in[3], *w_mod = a.in[4], *b_mod = a.in[5], *g_ffn1 = a.in[6], *ffn1_w_in = a.in[7], *ffn1_w_out = a.in[8],
                *g_mix = a.in[9], *w_in = a.in[10], *lq1 = a.in[11], *lk1 = a.in[12], *lq2 = a.in[13], *lk2 = a.in[14], *g_sub = a.in[15], *w_pool = a.in[16], *pool_scale = a.in[17],
                *w_out = a.in[18], *g_ffn2 = a.in[19], *ffn2_w_in = a.in[20], *ffn2_w_out = a.in[21], *g_final = a.in[22];
    float* mod = (float*)(ws + WS_MOD);
    bf16 *W1A = (bf16*)(ws + WS_W1A), *W2A = (bf16*)(ws + WS_W2A), *W1B = (bf16*)(ws + WS_W1B), *W2B = (bf16*)(ws + WS_W2B), *WINt = (bf16*)(ws + WS_WIN), *WOUTt = (bf16*)(ws + WS_WOUT), *WPt = (bf16*)(ws + WS_WP);
    bf16 *HN = (bf16*)(ws + WS_HN), *MIX = (bf16*)(ws + WS_HN), *ACT = (bf16*)(ws + WS_BIG), *HX = (bf16*)(ws + WS_BIG)  , *KP = (bf16*)(ws + WS_BIG + 68 * MiB), *VP = (bf16*)(ws + WS_BIG + 102 * MiB);
    float* X1 = (float*)(ws + WS_X1);
    float* xpart = (float*)(ws + 44 * MiB); unsigned* xcnt = (unsigned*)(ws + 700 * 1024);
    constexpr int I1 = (D / 64) * (2 * DFF / 32), I2 = (DFF / 64) * (D / 32), I3 = (D / 64) * (INW / 32), I4 = (D / 64) * (D / 32), I5 = 4 * 2 * 4;
#define CONV_RANGE(ilo, ihi, first_wg) do { const int fw_ = ((first_wg) < G) ? (first_wg) : 0; if (bx >= fw_) { LAS float* scr = (LAS float*)(lds + wave * 16384); \
        for (int it = (ilo) + (bx - fw_) * NWAVES + wave; it < (ihi); it += (G - fw_) * NWAVES) { int r = it; \
            if (r < I1) { transpose_mat_item(ffn1_w_in, D, 2 * DFF, W1A, true, r, scr, lane); continue; } r -= I1; \
            if (r < I1) { transpose_mat_item(ffn2_w_in, D, 2 * DFF, W1B, true, r, scr, lane); continue; } r -= I1; \
            if (r < I2) { transpose_mat_item(ffn1_w_out, DFF, D, W2A, false, r, scr, lane); continue; } r -= I2; \
            if (r < I2) { transpose_mat_item(ffn2_w_out, DFF, D, W2B, false, r, scr, lane); continue; } r -= I2; \
            if (r < I3) { transpose_mat_item(w_in, D, INW, WINt, false, r, scr, lane); continue; } r -= I3; \
            if (r < I4) { transpose_mat_item(w_out, D, D, WOUTt, false, r, scr, lane); continue; } r -= I4; \
            { const int gi = r >> 3; transpose_mat_item(w_pool + (size_t)gi * 128 * 128, 128, 128, WPt + (size_t)gi * 128 * 128, false, r & 7, scr, lane); } } } } while (0)
    const int lo = a.ph_lo, hi = a.ph_hi;
#define IN(k) (lo <= (k) && (k) < hi)
#define SEAM(k) do { if (IN(k) && IN((k) + 1)) xcd_barrier(bar); } while (0)

    if (tid < 4) ((volatile LAS unsigned*)(lds + 131072 + 64))[tid] = 0u;
    __syncthreads();
    if (IN(0)) {
        if (bx == 0) for (int i = tid; i < XCD_BAR_WORDS; i += 512) ((unsigned*)(ws + WS_BAR))[i] = 0u;
        for (int i = bx * 512 + tid; i < 3 * 128 * 64; i += G * 512) xcnt[i] = 0u;
        for (int u = bx; u < 144; u += G) adaln_unit(lds, u, c, c_ctx, w_mod, b_mod, mod, tid);
        CONV_RANGE(0, I1, 0); CONV_RANGE(2 * I1, 2 * I1 + I2, 0);
    }
    XcdBarrier bar; bar.bar = (unsigned*)(ws + WS_BAR); bar.x = 0; bar.st = nullptr;
    if (IN(0) && IN(1)) {
        cg::this_grid().sync();
        bar.bar = (unsigned*)(ws + WS_BAR); bar.x = xb_xcc_id(); bar.st = (volatile LAS unsigned*)(lds + 131072 + 64);
        if (tid == 0) bar.st[2] = xb_add(&bar.bar[XB_XCNT(bar.x)], 1u);
    }
    if (IN(1)) norm_pass(x, ctx, NTOK, g_ffn1, mod, 0, 1, HN, nullptr, wave, lane);
    SEAM(1);
    if (IN(2)) { pg8::Gemm g{HN, W1A, NTOK, 2 * DFF, D}; pg8::StaticOrder S; S.init(NTOK, 2 * DFF, G, bx, D); pg8::EpiSwiglu E{ACT, DFF};
        pg8::gemm_phase<pg8::EpiSwiglu, pg8::StaticOrder, true, true>(lds, g, S, E);
        CONV_RANGE(2 * I1 + 2 * I2, 2 * I1 + 2 * I2 + I3 + I4 + I5, ((NTOK / 256) * (2 * DFF / 256)) % G); }
    SEAM(2);
    if (IN(3)) { pg8::Gemm g{ACT, W2A, NTOK, D, DFF};
        { pg8::StaticOrder S; S.init(NLAT, D, G, bx, DFF);
          pg8::EpiResidRms<1, false> E{x, X1, mod + 2 * D, g_mix, mod + 4 * D, mod + 3 * D, HN, xpart, xcnt, (PG8_LAS float*)(lds + 131072 + 1024), nullptr};
          pg8::gemm_phase<pg8::EpiResidRms<1, false>, pg8::StaticOrder, true, true>(lds, g, S, E); }
        { pg8::SplitOnlyOrder S; S.init(NLAT, G, bx);
          pg8::EpiSplitRaw E{a.out};
          pg8::gemm_phase<pg8::EpiSplitRaw, pg8::SplitOnlyOrder, true, true>(lds, g, S, E); }
        CONV_RANGE(2 * I1 + I2, 2 * I1 + 2 * I2, 128); }
    SEAM(3);
    if (IN(4)) norm_pass(X1, ctx, NTOK, g_mix, mod, 3, 4, HN, nullptr, wave, lane, a.out, mod + (size_t)8 * NMOD + 2 * D, NLAT);
    SEAM(4);
    if (IN(5)) { pg8::Gemm g{HN, WINt, NTOK, INW, D}; pg8::StaticOrder S; S.init(NTOK, INW, G, bx, D); pg8::EpiInproj E{HX, KP, VP, QSCALE};
        pg8::gemm_phase<pg8::EpiInproj, pg8::StaticOrder, true, true>(lds, g, S, E);
        CONV_RANGE(I1, 2 * I1, ((NTOK / 256) * (INW / 256)) % G); }
    SEAM(5);
    if (IN(6)) {
        { u32x4 pv[5], pw_[4]; int u = bx;
          if (u < 1024) pool_load(u >> 2, (u + (u >> 8)) & 3, HX, WPt, pv, pw_, tid);
          for (; u < 1024; u += G) { pool_stage(lds, pv, pw_, tid); __syncthreads();
              const int un = u + G; if (un < 1024) pool_load(un >> 2, (un + (un >> 8)) & 3, HX, WPt, pv, pw_, tid);
              pool_compute(lds, u >> 2, (u + (u >> 8)) & 3, pool_scale, MIX, tid, wave, lane); } }
        __syncthreads();
        float d1 = 0.f, d2 = 0.f;
        for (int i = 0; i < 64; ++i) { d1 += lq1[i] * lk1[i]; d2 += lq2[i] * lk2[i]; }
        if (tid < 128) ((LAS float*)(lds + 131072 + 2048))[tid] = g_sub[tid];
        const float lam = __expf(d1) - __expf(d2) + LAM_INIT;
        int xcd = bx & 7, j = bx >> 3;
        if (IN(0)) {
            bool okc = (G == 256);
            for (int q = 0; q < 8; ++q) okc = okc && (xb_ld(&bar.bar[XB_XCNT(q)]) == 32u);
            if (okc && bar.x < 8u) { xcd = (int)bar.x; j = (int)((volatile LAS unsigned*)(lds + 131072 + 64))[2]; }
        }
        for (int u = j; u < 128; u += (G >> 3)) { const int bh = 4 * xcd + (u >> 5), qb = u & 31; attn_unit<0>(lds, bh >> 2, bh & 3, qb, HX, KP, VP, MIX, g_sub, lam, tid, wave, lane); }
    }
    SEAM(6);
    if (IN(7)) { pg8::Gemm g{MIX, WOUTt, NLAT, D, D}; pg8::StaticOrder S; S.init(NLAT, D, G, bx, D);
        pg8::EpiResidRms<2, false> E{X1, X1, mod + 5 * D, g_ffn2, mod + 7 * D, mod + 6 * D, (bf16*)a.out, xpart, xcnt + 1 * 128 * 64, (PG8_LAS float*)(lds + 131072 + 1024), nullptr};
        pg8::gemm_phase<pg8::EpiResidRms<2, false>, pg8::StaticOrder, true, true>(lds, g, S, E); }
    SEAM(7);
    if (IN(9)) { pg8::Gemm g{(const bf16*)a.out, W1B, NLAT, 2 * DFF, D}; pg8::StaticOrder S; S.init(NLAT, 2 * DFF, G, bx, D); pg8::EpiSwiglu E{ACT, DFF};
        pg8::gemm_phase<pg8::EpiSwiglu, pg8::StaticOrder, true, true>(lds, g, S, E); }
    SEAM(9);
    if (IN(10)) { pg8::Gemm g{ACT, W2B, NLAT, D, DFF}; pg8::StaticOrder S; S.init(NLAT, D, G, bx, DFF);
        pg8::EpiResidRms<1, true> E{X1, a.out, mod + 8 * D, g_final, nullptr, nullptr, nullptr, xpart, xcnt + 2 * 128 * 64, (PG8_LAS float*)(lds + 131072 + 1024), nullptr};
        pg8::gemm_phase<pg8::EpiResidRms<1, true>, pg8::StaticOrder, true, true>(lds, g, S, E); }
#undef IN
#undef CONV_RANGE
#undef SEAM
}

extern "C" void kernel_launch(void* const* d_in, const int* in_sizes, int n_in, void* d_out, int out_size, void* d_ws, size_t ws_size, hipStream_t stream) {
    static int grid = 0;
    if (grid == 0) {
        if (n_in != 23 || in_sizes[0] != NLAT * D || out_size != NLAT * D || ws_size < WS_END) { fprintf(stderr, "kernel_launch: unexpected shapes (n_in %d, in0 %d, out %d, ws %zu)\n", n_in, n_in > 0 ? in_sizes[0] : -1, out_size, ws_size); grid = -1; return; }
        int dev = 0, cus = 0, per_cu = 0;
        if (hipGetDevice(&dev) != hipSuccess || hipDeviceGetAttribute(&cus, hipDeviceAttributeMultiprocessorCount, dev) != hipSuccess) { grid = -1; return; }
        if (hipFuncSetAttribute((const void*)mk_fwd, hipFuncAttributeMaxDynamicSharedMemorySize, LDS_BYTES) != hipSuccess) { fprintf(stderr, "kernel_launch: hipFuncSetAttribute failed\n"); grid = -1; return; }
        if (hipOccupancyMaxActiveBlocksPerMultiprocessor(&per_cu, (const void*)mk_fwd, NWAVES * 64, LDS_BYTES) != hipSuccess || per_cu < 1) { fprintf(stderr, "kernel_launch: occupancy query says %d blocks/CU\n", per_cu); grid = -1; (void)hipGetLastError(); return; }
        grid = cus;
    }
    if (grid < 0) return;
    Args a{};
    for (int i = 0; i < 23; ++i) a.in[i] = (const float*)d_in[i];
    a.out = (float*)d_out; a.ws = (unsigned char*)d_ws;
#if MK_N_LAUNCHES == 1
    a.ph_lo = 0; a.ph_hi = NPHASE;
    void* args[] = {&a};
    hipError_t e = hipLaunchCooperativeKernel((const void*)mk_fwd, dim3(grid), dim3(NWAVES * 64), args, LDS_BYTES, stream);
    if (e != hipSuccess) fprintf(stderr, "kernel_launch: cooperative launch failed: %s (grid %d)\n", hipGetErrorString(e), grid);
#else
    for (int p = 0; p < NPHASE; ++p) { a.ph_lo = p; a.ph_hi = p + 1; hipLaunchKernelGGL(mk_fwd, dim3(grid), dim3(NWAVES * 64), LDS_BYTES, stream, a); }
#endif
}
```

```cpp
#include <hip/hip_runtime.h>
#include <cstdio>
#include <cstdint>
#include <cmath>
namespace pg8 {
#define PG8_LAS __attribute__((address_space(3)))
typedef unsigned short bf16_t;
typedef short bf16x8 __attribute__((ext_vector_type(8)));
typedef float f32x4 __attribute__((ext_vector_type(4)));
typedef unsigned u32x4 __attribute__((ext_vector_type(4)));
constexpr int BM = 256, BK = 64, HALF = 128, HTB = HALF * BK * 2  , STAGE_BYTES = 8 * HTB, NXCD = 8, WGM = 8;

__host__ __device__ __forceinline__ int lds_byte(int r, int c) { const int st = (r >> 4) * 2 + (c >> 5), rr = r & 15, cc = c & 31, ob = rr * 64 + cc * 2; return st * 1024 + (ob ^ (((ob >> 9) & 1) << 5)); }
__host__ __device__ __forceinline__ void stage_rc(int b, int& R, int& C) { const int st = b / 1024, sb = b % 1024, swz = sb ^ (((sb >> 9) & 1) << 5); R = (st >> 1) * 16 + swz / 64; C = (st & 1) * 32 + (swz % 64) / 2; }
__host__ __device__ __forceinline__ int perm32(int rho) { const int n = rho >> 4, i = rho & 15; return 8 * (i >> 2) + 4 * n + (i & 3); }

struct Unit { int pm, pn, kt0, nk; };
struct Gemm { const bf16_t* A; const bf16_t* Bt; int M, N, K; };

struct StaticOrder {
    int nM, nN, nwg, G, c, nkt;
    __host__ __device__ void init(int M, int N, int G_, int c_, int K_) { nM = M / BM; nN = N / BM; nwg = nM * nN; G = G_; c = c_; nkt = K_ / BK; }
    __host__ __device__ bool next(int i, Unit& u) const {
        const long L = (long)i * G + c; if (L >= nwg) return false;
        int wgid = (int)L; { const int q = nwg / NXCD, r = nwg % NXCD, xcd = wgid % NXCD, off = wgid / NXCD; wgid = (xcd < r ? xcd * (q + 1) : r * (q + 1) + (xcd - r) * q) + off; }
        const int nig = WGM * nN, gid = wgid / nig, fm = gid * WGM, gsz = (nM - fm) < WGM ? (nM - fm) : WGM;
        u.pm = fm + ((wgid % nig) % gsz); u.pn = (wgid % nig) / gsz; u.kt0 = 0; u.nk = nkt; return true;
    }
    __device__ __forceinline__ void a_ready(const Unit&) const {}
    __device__ __forceinline__ void done(const Unit&) const {}
};

struct SplitOrder {
    StaticOrder S; int nfull, G, c;
    __host__ __device__ void init(int Mlat, int N, int G_, int c_, int K_) { S.init(Mlat, N, G_, c_, K_); nfull = S.nwg; G = G_; c = c_; }
    __host__ __device__ bool next(int i, Unit& u) const {
        const long L = (long)i * G + c;
        if (L < nfull) return S.next(i, u);
        const int idx = (int)(L - nfull); if (idx >= 128) return false;
        const int un = idx >> 2, s = idx & 3; u.pm = S.nM + (un >> 2); u.pn = un & 3; u.kt0 = 12 * s; u.nk = (s == 3) ? 8 : 12; return true;
    }
    __device__ __forceinline__ void a_ready(const Unit&) const {}
    __device__ __forceinline__ void done(const Unit&) const {}
};
struct SplitOnlyOrder {
    int nMlat, G, c;
    __host__ __device__ void init(int Mlat, int G_, int c_) { nMlat = Mlat / BM; G = G_; c = c_; }
    __host__ __device__ bool next(int i, Unit& u) const {
        const long L = (long)i * G + c; if (L >= 128) return false;
        const int idx = (int)L, un = idx >> 2, s = idx & 3; u.pm = nMlat + (un >> 2); u.pn = un & 3; u.kt0 = 12 * s; u.nk = (s == 3) ? 8 : 12; return true;
    }
    __device__ __forceinline__ void a_ready(const Unit&) const {}
    __device__ __forceinline__ void done(const Unit&) const {}
};
__device__ __forceinline__ unsigned cvt_pk_bf16(float lo, float hi) { unsigned r; asm volatile("v_cvt_pk_bf16_f32 %0, %1, %2" : "=v"(r) : "v"(lo), "v"(hi)); return r; }
typedef float f32x2 __attribute__((ext_vector_type(2)));
__device__ __forceinline__ f32x2 gelu_pk(f32x2 v) {
    const f32x2 av = __builtin_elementwise_abs(v), d = av * 0.2316418882f + 1.0f;
    f32x2 t; t.x = __builtin_amdgcn_rcpf(d.x); t.y = __builtin_amdgcn_rcpf(d.y);
    f32x2 q = t * 0.5307027145f + (-0.7265760135f); q = q * t + 0.7107068705f; q = q * t + (-0.142248368f); q = q * t + 0.127414796f; q = q * t;
    const f32x2 s = (v * v) * (-0.72134752044f);
    f32x2 e; e.x = __builtin_amdgcn_exp2f(s.x); e.y = __builtin_amdgcn_exp2f(s.y);
    const f32x2 m = v * (q * e), r = v - m;
    f32x2 o; o.x = v.x < 0.f ? m.x : r.x; o.y = v.y < 0.f ? m.y : r.y; return o;
}

typedef unsigned u32x2 __attribute__((ext_vector_type(2)));
__device__ __forceinline__ float silu_f(float g) { return g * __builtin_amdgcn_rcpf(1.0f + __builtin_amdgcn_exp2f(-1.4426950408889634f * g)); }
struct EpiSwiglu {
    static constexpr bool PERM = true, AFTER_DRAIN = false;
    bf16_t* O; int ldo;
    __device__ __forceinline__ void operator()(const f32x4 (&acc)[2][2][4][2], const Unit& u, int wr, int wc, int fr, int fq) const {
        const int row0 = u.pm * BM + wr * 64 + fr, col0 = u.pn * HALF + wc * 32 + 8 * fq;
#pragma unroll
        for (int ai = 0; ai < 2; ++ai)
#pragma unroll
            for (int m = 0; m < 4; ++m) {
                bf16_t* p = O + (size_t)(row0 + ai * HALF + m * 16) * ldo + col0;
                const f32x4 g0 = acc[ai][0][m][0], g1 = acc[ai][0][m][1], u0 = acc[ai][1][m][0], u1 = acc[ai][1][m][1];
                u32x4 w;
                w.x = cvt_pk_bf16(silu_f(g0[0]) * u0[0], silu_f(g0[1]) * u0[1]); w.y = cvt_pk_bf16(silu_f(g0[2]) * u0[2], silu_f(g0[3]) * u0[3]);
                w.z = cvt_pk_bf16(silu_f(g1[0]) * u1[0], silu_f(g1[1]) * u1[1]); w.w = cvt_pk_bf16(silu_f(g1[2]) * u1[2], silu_f(g1[3]) * u1[3]);
                __builtin_nontemporal_store(w, (u32x4*)p);
            }
    }
};
struct EpiResid {
    static constexpr bool PERM = false, AFTER_DRAIN = false;
    const float* rlat; const float* rctx; float* out; const float* gate  ; float coef;
    __device__ __forceinline__ void operator()(const f32x4 (&acc)[2][2][4][2], const Unit& u, int wr, int wc, int fr, int fq) const {
        const bool lat = u.pm < 128; const int rix = lat ? (u.pm >> 4) : 8;
        const float* rb = lat ? rlat + (size_t)u.pm * BM * 1024 : rctx + (size_t)(u.pm - 128) * BM * 1024;
        float* ob = out + (size_t)u.pm * BM * 1024;
        const int col0 = u.pn * BM + wc * 32 + 4 * fq;
        f32x4 gv[2][2];
#pragma unroll
        for (int bj = 0; bj < 2; ++bj)
#pragma unroll
            for (int n = 0; n < 2; ++n) gv[bj][n] = *(const f32x4*)(gate + (size_t)rix * 9216 + col0 + bj * HALF + n * 16) * coef;
#pragma unroll
        for (int ai = 0; ai < 2; ++ai)
#pragma unroll
            for (int m = 0; m < 4; ++m) { const size_t off = (size_t)(ai * HALF + wr * 64 + m * 16 + fr) * 1024 + col0;
#pragma unroll
                for (int bj = 0; bj < 2; ++bj)
#pragma unroll
                    for (int n = 0; n < 2; ++n) { const f32x4 r = *(const f32x4*)(rb + off + bj * HALF + n * 16);
                        *(f32x4*)(ob + off + bj * HALF + n * 16) = r + gv[bj][n] * acc[ai][bj][m][n]; }
                if (m & 1) asm volatile("" ::: "memory"); }
    }
};
struct EpiResidS {
    static constexpr bool PERM = false, AFTER_DRAIN = false;
    const float* rlat; float* out; const float* gate; float* part;
    __device__ __forceinline__ void operator()(const f32x4 (&acc)[2][2][4][2], const Unit& u, int wr, int wc, int fr, int fq) const {
        const float* rlat_ = rlat; float* out_ = out; const float* gate_ = gate; float* part_ = part;
        const int col0 = u.pn * BM + wc * 32 + 4 * fq;
        if (u.pm >= 128) {
            float* pb = part_ + (size_t)(u.kt0 / 12) * (2048 * 1024) + (size_t)(u.pm - 128) * BM * 1024;
#pragma unroll
            for (int ai = 0; ai < 2; ++ai)
#pragma unroll
                for (int m = 0; m < 4; ++m) { const size_t off = (size_t)(ai * HALF + wr * 64 + m * 16 + fr) * 1024 + col0;
#pragma unroll
                    for (int bj = 0; bj < 2; ++bj)
#pragma unroll
                        for (int n = 0; n < 2; ++n) *(f32x4*)(pb + off + bj * HALF + n * 16) = acc[ai][bj][m][n]; }
            return;
        }
        const int rix = u.pm >> 4;
        const float* rb = rlat_ + (size_t)u.pm * BM * 1024; float* ob = out_ + (size_t)u.pm * BM * 1024;
        f32x4 gv[2][2];
#pragma unroll
        for (int bj = 0; bj < 2; ++bj)
#pragma unroll
            for (int n = 0; n < 2; ++n) gv[bj][n] = *(const f32x4*)(gate_ + (size_t)rix * 9216 + col0 + bj * HALF + n * 16) * 0.5f;
#pragma unroll
        for (int ai = 0; ai < 2; ++ai)
#pragma unroll
            for (int m = 0; m < 4; ++m) { const size_t off = (size_t)(ai * HALF + wr * 64 + m * 16 + fr) * 1024 + col0;
#pragma unroll
                for (int bj = 0; bj < 2; ++bj)
#pragma unroll
                    for (int n = 0; n < 2; ++n) { const f32x4 r = *(const f32x4*)(rb + off + bj * HALF + n * 16);
                        *(f32x4*)(ob + off + bj * HALF + n * 16) = r + gv[bj][n] * acc[ai][bj][m][n]; }
                if (m & 1) asm volatile("" ::: "memory"); }
    }
};
template <int COEF2, bool FINAL> struct EpiResidRms {
    static constexpr bool PERM = false, AFTER_DRAIN = false;
    const float* resid; float* xout; const float* gate; const float* g; const float* scm; const float* shm; bf16_t* hn; float* part; unsigned* cnt; PG8_LAS float* tab; float* splitpart  ;
    __device__ __forceinline__ void operator()(const f32x4 (&acc_c)[2][2][4][2], const Unit& u, int wr, int wc, int fr_in, int fq_in) const {
        f32x4 (&acc)[2][2][4][2] = const_cast<f32x4 (&)[2][2][4][2]>(acc_c);
        int fr = fr_in, fq = fq_in; asm volatile("" : "+v"(fr), "+v"(fq));
        if (splitpart != nullptr && u.pm >= 128) {
            float* sb = splitpart + (size_t)(u.kt0 / 12) * (2048 * 1024) + (size_t)(u.pm - 128) * BM * 1024; const int c0 = u.pn * BM + wc * 32 + 4 * fq;
#pragma unroll
            for (int ai = 0; ai < 2; ++ai)
#pragma unroll
                for (int m = 0; m < 4; ++m) { const size_t off = (size_t)(ai * HALF + wr * 64 + m * 16 + fr) * 1024 + c0;
#pragma unroll
                    for (int bj = 0; bj < 2; ++bj)
#pragma unroll
                        for (int n = 0; n < 2; ++n) *(f32x4*)(sb + off + bj * HALF + n * 16) = acc[ai][bj][m][n]; }
            return;
        }
        const float* resid_ = resid; float* xout_ = xout; const float* gate_ = gate; const float* g_ = g; const float* scm_ = scm; const float* shm_ = shm; bf16_t* hn_ = hn; float* part_ = part; unsigned* cnt_ = cnt; PG8_LAS float* tab_ = tab;
        const int rix = u.pm >> 4, col0 = u.pn * BM + wc * 32 + 4 * fq, wid = wr * 4 + wc, lane = fq * 16 + fr, tid = wid * 64 + lane;
        const float* rb = resid_ + (size_t)u.pm * BM * 1024; float* pb = part_ + (size_t)u.pm * BM * 16 + u.pn * 4 + wc;
        PG8_LAS float* vec = tab_ + 384; const int cl = wc * 32 + 4 * fq;
        if (tid < 256) { const int c = u.pn * BM + tid; vec[tid] = gate_[(size_t)rix * 9216 + c] * (0.5f * COEF2);
            if (FINAL) vec[256 + tid] = g_[c]; else { vec[256 + tid] = g_[c] * (scm_[(size_t)rix * 9216 + c] + 1.0f); vec[512 + tid] = shm_[(size_t)rix * 9216 + c]; } }
        asm volatile("s_waitcnt vmcnt(0) lgkmcnt(0)" ::: "memory"); __builtin_amdgcn_s_barrier(); asm volatile("" ::: "memory");
        {
#pragma unroll
          for (int ap = 0; ap < 4; ++ap) { const int ai = ap >> 1, m0 = (ap & 1) * 2; f32x4 rr[2][2][2];
              asm volatile("" ::: "memory");
#pragma unroll
              for (int mm = 0; mm < 2; ++mm) { const size_t off = (size_t)(ai * HALF + wr * 64 + (m0 + mm) * 16 + fr) * 1024 + col0;
#pragma unroll
                  for (int bj = 0; bj < 2; ++bj)
#pragma unroll
                      for (int n = 0; n < 2; ++n) rr[mm][bj][n] = __builtin_nontemporal_load((const f32x4*)(rb + off + bj * HALF + n * 16)); }
#pragma unroll
              for (int mm = 0; mm < 2; ++mm) { const int m = m0 + mm, rl = ai * HALF + wr * 64 + m * 16 + fr; float ss = 0.f;
#pragma unroll
                  for (int bj = 0; bj < 2; ++bj)
#pragma unroll
                      for (int n = 0; n < 2; ++n) { const f32x4 gv = *(const PG8_LAS f32x4*)(vec + cl + bj * HALF + n * 16); const f32x4 o = rr[mm][bj][n] + gv * acc[ai][bj][m][n];
                          acc[ai][bj][m][n] = o; ss += (o[0] * o[0] + o[1] * o[1]) + (o[2] * o[2] + o[3] * o[3]); }
                  ss += __shfl_xor(ss, 16); ss += __shfl_xor(ss, 32);
                  if (fq == 0) __hip_atomic_store(pb + (size_t)rl * 16, ss, __ATOMIC_RELAXED, __HIP_MEMORY_SCOPE_AGENT); } } }
        asm volatile("s_waitcnt vmcnt(0)" ::: "memory");
        unsigned* cw = cnt_ + 64 * u.pm;
        if (lane == 0) __hip_atomic_fetch_add(cw, 1u, __ATOMIC_RELAXED, __HIP_MEMORY_SCOPE_AGENT);
        if (wid == 0) { unsigned sp = 0;
            while ((unsigned)__builtin_amdgcn_readfirstlane(__hip_atomic_load(cw, __ATOMIC_RELAXED, __HIP_MEMORY_SCOPE_AGENT)) < 32u) { __builtin_amdgcn_s_sleep(2); if (++sp > (1u << 22)) break; } }
        asm volatile("s_waitcnt vmcnt(0) lgkmcnt(0)" ::: "memory"); __builtin_amdgcn_s_barrier(); asm volatile("" ::: "memory");
        if (tid < 256) { const unsigned long long* pp = (const unsigned long long*)(part_ + ((size_t)u.pm * BM + tid) * 16); float s = 0.f;
#pragma unroll
            for (int q = 0; q < 8; ++q) { const unsigned long long w = __hip_atomic_load(pp + q, __ATOMIC_RELAXED, __HIP_MEMORY_SCOPE_AGENT); s += __uint_as_float((unsigned)w) + __uint_as_float((unsigned)(w >> 32)); }
            tab_[tid] = 1.0f / sqrtf(s * (1.0f / 1024.0f) + 1e-6f); }
        asm volatile("s_waitcnt vmcnt(0) lgkmcnt(0)" ::: "memory"); __builtin_amdgcn_s_barrier(); asm volatile("" ::: "memory");
        { float* ob = xout_ + (size_t)u.pm * BM * 1024; bf16_t* hb = hn_ + (size_t)u.pm * BM * 1024;
#pragma unroll
          for (int ai = 0; ai < 2; ++ai)
#pragma unroll
            for (int m = 0; m < 4; ++m) { const int rl = ai * HALF + wr * 64 + m * 16 + fr; const size_t off = (size_t)rl * 1024 + col0; const float rs = tab_[rl];
#pragma unroll
                for (int bj = 0; bj < 2; ++bj)
#pragma unroll
                    for (int n = 0; n < 2; ++n) { const f32x4 gs = *(const PG8_LAS f32x4*)(vec + 256 + cl + bj * HALF + n * 16); const f32x4 o = acc[ai][bj][m][n];
                        if (FINAL) *(f32x4*)(ob + off + bj * HALF + n * 16) = o * rs * gs;
                        else { const f32x4 sh = *(const PG8_LAS f32x4*)(vec + 512 + cl + bj * HALF + n * 16);
                               __builtin_nontemporal_store(o, (f32x4*)(ob + off + bj * HALF + n * 16));     const f32x4 a = o * rs * gs + sh; u32x2 w; w.x = cvt_pk_bf16(a[0], a[1]); w.y = cvt_pk_bf16(a[2], a[3]); *(u32x2*)(hb + off + bj * HALF + n * 16) = w; } } }
        }
        asm volatile("s_waitcnt lgkmcnt(0)" ::: "memory"); __builtin_amdgcn_s_barrier(); asm volatile("" ::: "memory");
    }
};
struct EpiSplitRaw {
    static constexpr bool PERM = false, AFTER_DRAIN = false;
    float* part;
    __device__ __forceinline__ void operator()(const f32x4 (&acc)[2][2][4][2], const Unit& u, int wr, int wc, int fr, int fq) const {
        float* sb = part + (size_t)(u.kt0 / 12) * (2048 * 1024) + (size_t)(u.pm - 128) * BM * 1024; const int c0 = u.pn * BM + wc * 32 + 4 * fq;
#pragma unroll
        for (int ai = 0; ai < 2; ++ai)
#pragma unroll
            for (int m = 0; m < 4; ++m) { const size_t off = (size_t)(ai * HALF + wr * 64 + m * 16 + fr) * 1024 + c0;
#pragma unroll
                for (int bj = 0; bj < 2; ++bj)
#pragma unroll
                    for (int n = 0; n < 2; ++n) *(f32x4*)(sb + off + bj * HALF + n * 16) = acc[ai][bj][m][n]; }
    }
};
struct EpiInproj {
    static constexpr bool PERM = false, AFTER_DRAIN = false;
    bf16_t* HQ; bf16_t* KP; bf16_t* VP; float qs;
    __device__ __forceinline__ void operator()(const f32x4 (&acc)[2][2][4][2], const Unit& u, int wr, int wc, int fr, int fq) const {
        const int tt = u.pn >> 1; const bool lat = u.pm < 128; const bool rope = (tt < 2) && lat;
        const int row0 = u.pm * BM + wr * 64 + fr, cw = wc * 32 + 4 * fq;
        float fr4[4];
#pragma unroll
        for (int e = 0; e < 4; ++e) fr4[e] = __builtin_amdgcn_exp2f(-(float)(4 * fq + e) * (13.287712379549449f / 16.0f)) * 0.15915494309189535f;
        const float sc = (tt == 0) ? qs : 1.0f;
#pragma unroll
        for (int ai = 0; ai < 2; ++ai)
#pragma unroll
            for (int m = 0; m < 4; ++m) { const int row = row0 + ai * HALF + m * 16;
                bf16_t* p;
                if (tt == 0) p = HQ + (size_t)row * 512 + (u.pn & 1) * 256 + cw;
                else if (tt == 3) p = HQ + (size_t)34816 * 512 + ((size_t)((u.pn & 1) * 2) * 34816 + row) * 128 + cw;
                else { const int b = lat ? (row >> 12) : ((row - 32768) >> 8), kv = lat ? (row & 4095) : 4096 + ((row - 32768) & 255);
                       p = (tt == 1 ? KP : VP) + ((size_t)(b * 4 + (u.pn & 1) * 2) * 4352 + kv) * 128 + cw; }
                const size_t bjs = (tt == 0) ? (size_t)HALF : (tt == 3) ? (size_t)34816 * 128 : (size_t)4352 * 128;
                float cs[4], sn[4];
                if (rope) { const int t = row & 4095; const float pos = (float)((wc & 1) ? (t & 63) : (t >> 6));
#pragma unroll
                    for (int e = 0; e < 4; ++e) { const float rev = __builtin_amdgcn_fractf(pos * fr4[e]); cs[e] = __builtin_amdgcn_cosf(rev) * sc; sn[e] = __builtin_amdgcn_sinf(rev) * sc; } }
                else {
#pragma unroll
                    for (int e = 0; e < 4; ++e) { cs[e] = sc; sn[e] = 0.f; } }
#pragma unroll
                for (int bj = 0; bj < 2; ++bj) { const f32x4 a0 = acc[ai][bj][m][0], a1 = acc[ai][bj][m][1]; float o0[4], o1[4];
#pragma unroll
                    for (int e = 0; e < 4; ++e) { o0[e] = a0[e] * cs[e] - a1[e] * sn[e]; o1[e] = a1[e] * cs[e] + a0[e] * sn[e]; }
                    u32x2 w0, w1; w0.x = cvt_pk_bf16(o0[0], o0[1]); w0.y = cvt_pk_bf16(o0[2], o0[3]); w1.x = cvt_pk_bf16(o1[0], o1[1]); w1.y = cvt_pk_bf16(o1[2], o1[3]);
                    *(u32x2*)(p + bj * bjs) = w0; *(u32x2*)(p + bj * bjs + 16) = w1; }
            }
    }
};
template <class Epi, class Sched, bool ALIGN_EPI = false, bool SP2 = false>
__device__ __forceinline__ void gemm_phase(PG8_LAS unsigned char* lds, const Gemm g, const Sched& S, const Epi& E) {
    int tid_l = threadIdx.x; asm volatile("" : "+v"(tid_l));
    const int tid = tid_l, wid = __builtin_amdgcn_readfirstlane(tid >> 6), lane = tid & 63, wr = wid >> 2, wc = wid & 3, fr = lane & 15, fq = lane >> 4;
    const int K = g.K; int nt = 0;
    unsigned voffA[2], voffB[2];
#pragma unroll
    for (int i = 0; i < 2; ++i) { int R, C; stage_rc(tid * 16 + i * 8192, R, C); const int Rb = Epi::PERM ? ((R & ~31) + perm32(R & 31)) : R;
        voffA[i] = (unsigned)(R * K + C) * 2u; voffB[i] = (unsigned)(Rb * K + C) * 2u; }
    const size_t kstep = (size_t)(BK * 2);
    const size_t hstep = (size_t)HALF * K * 2;
    const size_t tstep = 2 * hstep;
    const unsigned ldsw = (unsigned)wid * 1024u;
    const int aoff = lds_byte(wr * 64 + fr, fq * 8), boff = lds_byte(wc * 32 + fr, fq * 8);
#define PG8_SA(b, h) (((b) * 2 + (h)) * HTB)
#define PG8_SB(b, h) ((4 + (b) * 2 + (h)) * HTB)
#define PG8_STAGE(bufoff, gbase, voff) do { _Pragma("unroll") for (int _i = 0; _i < 2; ++_i) \
        __builtin_amdgcn_global_load_lds((const unsigned*)((const char*)(gbase) + (voff)[_i]), (PG8_LAS unsigned*)(lds + (bufoff) + ldsw + _i * 8192), 16, 0, 0); } while (0)
#define PG8_LDA(dst, b, h) do { _Pragma("unroll") for (int m = 0; m < 4; ++m) _Pragma("unroll") for (int k = 0; k < 2; ++k) dst[m][k] = *(const PG8_LAS bf16x8*)(lds + PG8_SA(b, h) + aoff + m * 2048 + k * 1024); } while (0)
#define PG8_LDB(dst, b, h) do { _Pragma("unroll") for (int n = 0; n < 2; ++n) _Pragma("unroll") for (int k = 0; k < 2; ++k) dst[n][k] = *(const PG8_LAS bf16x8*)(lds + PG8_SB(b, h) + boff + n * 2048 + k * 1024); } while (0)
#define PG8_MMA(ai, bj, At, Bt) do { __builtin_amdgcn_s_setprio(1); _Pragma("unroll") for (int m = 0; m < 4; ++m) _Pragma("unroll") for (int n = 0; n < 2; ++n) _Pragma("unroll") for (int k = 0; k < 2; ++k) \
        acc[ai][bj][m][n] = __builtin_amdgcn_mfma_f32_16x16x32_bf16(Bt[n][k], At[m][k], acc[ai][bj][m][n], 0, 0, 0); __builtin_amdgcn_s_setprio(0); } while (0)
#define PG8_WAIT_V(n) asm volatile("s_waitcnt vmcnt(" #n ")" ::: "memory")
#define PG8_WAIT_L(n) asm volatile("s_waitcnt lgkmcnt(" #n ")" ::: "memory")
#define PG8_BAR __builtin_amdgcn_s_barrier()
#define PG8_SCHED __builtin_amdgcn_sched_barrier(0)
    Unit cur, nxt; int ui = 0;
    if (!S.next(0, cur)) return;
    f32x4 acc[2][2][4][2];
#pragma unroll
    for (int a = 0; a < 2; ++a)
#pragma unroll
        for (int b = 0; b < 2; ++b)
#pragma unroll
            for (int m = 0; m < 4; ++m)
#pragma unroll
                for (int n = 0; n < 2; ++n) acc[a][b][m][n] = (f32x4){0.f, 0.f, 0.f, 0.f};
    bf16x8 At[4][2], B0[2][2], B1[2][2];
    nt = cur.nk;
    const char* cA = (const char*)g.A + (size_t)cur.pm * tstep + (size_t)cur.kt0 * kstep; const char* cB = (const char*)g.Bt + (size_t)cur.pn * tstep + (size_t)cur.kt0 * kstep;
    S.a_ready(cur);
    if constexpr (SP2) {
        PG8_STAGE(PG8_SB(0, 0), cB, voffB); PG8_STAGE(PG8_SB(0, 1), cB + hstep, voffB); PG8_STAGE(PG8_SA(0, 0), cA, voffA); PG8_STAGE(PG8_SA(0, 1), cA + hstep, voffA);
        if (wr == 1) PG8_BAR;
        PG8_WAIT_V(2); PG8_BAR;
        PG8_STAGE(PG8_SB(1, 0), cB + kstep, voffB); PG8_STAGE(PG8_SA(1, 0), cA + kstep, voffA); PG8_STAGE(PG8_SB(1, 1), cB + hstep + kstep, voffB);
        PG8_WAIT_V(6); PG8_BAR;
    } else {
        PG8_STAGE(PG8_SB(0, 0), cB, voffB); PG8_STAGE(PG8_SA(0, 0), cA, voffA); PG8_STAGE(PG8_SB(0, 1), cB + hstep, voffB); PG8_STAGE(PG8_SA(0, 1), cA + hstep, voffA);
        if (wr == 1) PG8_BAR;
        PG8_WAIT_V(4); PG8_BAR;
        PG8_STAGE(PG8_SB(1, 0), cB + kstep, voffB); PG8_STAGE(PG8_SA(1, 0), cA + kstep, voffA); PG8_STAGE(PG8_SB(1, 1), cB + hstep + kstep, voffB);
        PG8_WAIT_V(6); PG8_BAR;
    }
    for (;;) {
        const bool has_next = S.next(ui + 1, nxt);
        const char* nA = has_next ? (const char*)g.A + (size_t)nxt.pm * tstep + (size_t)nxt.kt0 * kstep : cA; const char* nB = has_next ? (const char*)g.Bt + (size_t)nxt.pn * tstep + (size_t)nxt.kt0 * kstep : cB;
        for (int t = 0; t < nt; t += 2) {
            const bool last = (t == nt - 2);
            const char* a1 = cA + (size_t)(t + 1) * kstep;
            const char* a2 = last ? nA : cA + (size_t)(t + 2) * kstep; const char* b2 = last ? nB : cB + (size_t)(t + 2) * kstep;
            const char* a3 = a2 + kstep; const char* b3 = b2 + kstep;
            if (last && has_next) S.a_ready(nxt);
            if constexpr (SP2) {
            PG8_LDB(B0, 0, 0); PG8_LDB(B1, 0, 1); PG8_SCHED; PG8_LDA(At, 0, 0); PG8_STAGE(PG8_SA(1, 1), a1 + hstep, voffA);
            PG8_WAIT_V(8); PG8_WAIT_L(0); PG8_BAR; PG8_MMA(0, 0, At, B0); PG8_MMA(0, 1, At, B1); PG8_BAR; PG8_SCHED;
            PG8_LDA(At, 0, 1); PG8_STAGE(PG8_SB(0, 0), b2, voffB); PG8_STAGE(PG8_SB(0, 1), b2 + hstep, voffB); PG8_STAGE(PG8_SA(0, 0), a2, voffA);
            PG8_WAIT_V(8); PG8_WAIT_L(0); PG8_BAR; PG8_MMA(1, 0, At, B0); PG8_MMA(1, 1, At, B1); PG8_BAR; PG8_SCHED;
            PG8_LDB(B0, 1, 0); PG8_LDB(B1, 1, 1); PG8_SCHED; PG8_LDA(At, 1, 0); PG8_STAGE(PG8_SA(0, 1), a2 + hstep, voffA);
            PG8_WAIT_V(8); PG8_WAIT_L(0); PG8_BAR; PG8_MMA(0, 0, At, B0); PG8_MMA(0, 1, At, B1); PG8_BAR; PG8_SCHED;
            PG8_LDA(At, 1, 1); PG8_STAGE(PG8_SB(1, 0), b3, voffB); PG8_STAGE(PG8_SB(1, 1), b3 + hstep, voffB); PG8_STAGE(PG8_SA(1, 0), a3, voffA);
            PG8_WAIT_V(8); PG8_WAIT_L(0); PG8_BAR; PG8_MMA(1, 0, At, B0); PG8_MMA(1, 1, At, B1); PG8_BAR; PG8_SCHED;
            } else {
            PG8_LDB(B0, 0, 0); PG8_SCHED; PG8_LDA(At, 0, 0); PG8_STAGE(PG8_SA(1, 1), a1 + hstep, voffA);
            PG8_WAIT_L(8); PG8_BAR; PG8_WAIT_L(0); PG8_MMA(0, 0, At, B0); PG8_BAR; PG8_SCHED;
            PG8_LDB(B1, 0, 1); PG8_STAGE(PG8_SB(0, 0), b2, voffB);
            PG8_BAR; PG8_WAIT_L(0); PG8_MMA(0, 1, At, B1); PG8_BAR;
            PG8_LDA(At, 0, 1); PG8_STAGE(PG8_SA(0, 0), a2, voffA);
            PG8_BAR; PG8_WAIT_L(0); PG8_MMA(1, 0, At, B0); PG8_BAR; PG8_SCHED;
            PG8_STAGE(PG8_SB(0, 1), b2 + hstep, voffB);
            PG8_WAIT_V(6); PG8_BAR; PG8_MMA(1, 1, At, B1); PG8_BAR;
            PG8_LDB(B0, 1, 0); PG8_SCHED; PG8_LDA(At, 1, 0); PG8_STAGE(PG8_SA(0, 1), a2 + hstep, voffA);
            PG8_WAIT_L(8); PG8_BAR; PG8_WAIT_L(0); PG8_MMA(0, 0, At, B0); PG8_BAR; PG8_SCHED;
            PG8_LDB(B1, 1, 1); PG8_STAGE(PG8_SB(1, 0), b3, voffB);
            PG8_BAR; PG8_WAIT_L(0); PG8_MMA(0, 1, At, B1); PG8_BAR;
            PG8_LDA(At, 1, 1); PG8_STAGE(PG8_SA(1, 0), a3, voffA);
            PG8_BAR; PG8_WAIT_L(0); PG8_MMA(1, 0, At, B0); PG8_BAR; PG8_SCHED;
            PG8_STAGE(PG8_SB(1, 1), b3 + hstep, voffB);
            PG8_WAIT_V(6); PG8_BAR; PG8_MMA(1, 1, At, B1); PG8_BAR;
            }
        }
        if constexpr (ALIGN_EPI) { if (wr == 0) PG8_BAR; }
        if constexpr (!Epi::AFTER_DRAIN) { E(acc, cur, wr, wc, fr, fq); S.done(cur); }
        if (!has_next) break;
#pragma unroll
        for (int a = 0; a < 2; ++a)
#pragma unroll
            for (int b = 0; b < 2; ++b)
#pragma unroll
                for (int m = 0; m < 4; ++m)
#pragma unroll
                    for (int n = 0; n < 2; ++n) acc[a][b][m][n] = (f32x4){0.f, 0.f, 0.f, 0.f};
        cur = nxt; cA = nA; cB = nB; ++ui; nt = cur.nk;
        if constexpr (ALIGN_EPI) { if (wr == 1) PG8_BAR; }
    }
    PG8_WAIT_V(0);
    if constexpr (!ALIGN_EPI) { if (wr == 0) PG8_BAR; }
    PG8_BAR;
    if constexpr (Epi::AFTER_DRAIN) { E.fused(acc, cur, wr, wc, fr, fq, lds, wid, lane); S.done(cur); }
#undef PG8_SA
#undef PG8_SB
#undef PG8_STAGE
#undef PG8_LDA
#undef PG8_LDB
#undef PG8_MMA
#undef PG8_WAIT_V
#undef PG8_WAIT_L
#undef PG8_BAR
#undef PG8_SCHED
}
}

#include <hip/hip_cooperative_groups.h>
namespace cg = cooperative_groups;
#define LAS __attribute__((address_space(3)))
typedef unsigned short bf16;
typedef unsigned u32x4 __attribute__((ext_vector_type(4)));
typedef unsigned u32x2 __attribute__((ext_vector_type(2)));
typedef float f32x4 __attribute__((ext_vector_type(4)));
typedef float f32x16 __attribute__((ext_vector_type(16)));
typedef short bf16x8 __attribute__((ext_vector_type(8)));
typedef short s16x4 __attribute__((ext_vector_type(4)));

constexpr int D = 1024, NB = 8, SEQ = 4096, CTX = 256, DFF = 2816, NLAT = NB * SEQ  , NTOK = NLAT + NB * CTX  , INW = 2048, NMOD = 9 * D;
constexpr float EPS = 1e-6f, QSCALE = 0.125f * 1.4426950408889634f, LAM_INIT = 0.2f;
constexpr size_t MiB = 1u << 20;
constexpr size_t WS_BAR = 512 * 1024, WS_MOD = 0, WS_W1A = 1 * MiB, WS_W2A = 12 * MiB, WS_W1B = 18 * MiB, WS_W2B = 29 * MiB, WS_WIN = 35 * MiB, WS_WOUT = 39 * MiB, WS_WP = 41 * MiB,
                 WS_HN = 48 * MiB, WS_X1 = 116 * MiB, WS_BIG = 252 * MiB, WS_END = 440 * MiB;
static_assert(WS_HN + (size_t)NTOK * D * 2 <= WS_X1 && WS_X1 + (size_t)NTOK * D * 4 <= WS_BIG && WS_BIG + (size_t)NTOK * DFF * 2 <= WS_END, "ws map");
constexpr int LDS_BYTES = 147456, NWAVES = 8, NPHASE = 12;
#ifndef MK_N_LAUNCHES
#define MK_N_LAUNCHES 1
#endif

__device__ __forceinline__ unsigned f2bf(float f) { unsigned u = __builtin_bit_cast(unsigned, f); return (u + 0x7fffu + ((u >> 16) & 1u)) >> 16; }
__device__ __forceinline__ unsigned pk2(float lo, float hi) { return f2bf(lo) | (f2bf(hi) << 16); }
__device__ __forceinline__ unsigned cvtpk(float lo, float hi) { unsigned r; asm volatile("v_cvt_pk_bf16_f32 %0, %1, %2" : "=v"(r) : "v"(lo), "v"(hi)); return r; }
__device__ __forceinline__ float bflo(unsigned w) { return __builtin_bit_cast(float, w << 16); }
__device__ __forceinline__ float bfhi(unsigned w) { return __builtin_bit_cast(float, w & 0xffff0000u); }
__device__ __forceinline__ float wave_sum(float v) {
#pragma unroll
    for (int o = 1; o < 64; o <<= 1) v += __shfl_xor(v, o);
    return v;
}
__device__ __forceinline__ int crow(int r, int hi) { return (r & 3) + 8 * (r >> 2) + 4 * hi; }

__device__ __forceinline__ void adaln_unit(LAS unsigned char* lds, int unit, const float* c, const float* c_ctx, const float* w_mod, const float* b_mod, float* mod, int tid) {
    LAS float* scond = (LAS float*)lds;
    LAS float* part = (LAS float*)(lds + 36864);
    for (int i = tid; i < 9 * D; i += 512) { const int r = i >> 10, k = i & 1023; const float v = (r < 8) ? c[r * D + k] : c_ctx[k]; scond[i] = v / (1.0f + __expf(-v)); }
    __syncthreads();
    const int cgp = tid & 15, ks = tid >> 4;
    f32x4 acc[9];
#pragma unroll
    for (int r = 0; r < 9; ++r) acc[r] = (f32x4){0.f, 0.f, 0.f, 0.f};
    const float* wp = w_mod + (size_t)(32 * ks) * NMOD + 64 * unit + 4 * cgp;
#pragma unroll 8
    for (int kk = 0; kk < 32; ++kk) { const f32x4 w = *(const f32x4*)(wp + (size_t)kk * NMOD);
#pragma unroll
        for (int r = 0; r < 9; ++r) acc[r] += w * scond[r * D + 32 * ks + kk]; }
#pragma unroll
    for (int r = 0; r < 9; ++r) *(LAS f32x4*)(part + (ks * 9 + r) * 64 + 4 * cgp) = acc[r];
    __syncthreads();
    for (int o = tid; o < 9 * 64; o += 512) { const int r = o >> 6, cc = o & 63; float s = 0.f;
#pragma unroll 8
        for (int k2 = 0; k2 < 32; ++k2) s += part[(k2 * 9 + r) * 64 + cc];
        mod[(size_t)r * NMOD + 64 * unit + cc] = s + b_mod[64 * unit + cc]; }
    __syncthreads();
}
__device__ __forceinline__ void transpose_item(const float* W, int ldw, bf16* WT, int ldt, int k0, int n0, int drow0, LAS float* scr, int lane) {
#pragma unroll 8
    for (int i = 0; i < 32; ++i) { const int kk = 2 * i + (lane >> 5); scr[kk * 33 + (lane & 31)] = W[(size_t)(k0 + kk) * ldw + n0 + (lane & 31)]; }
    asm volatile("s_waitcnt lgkmcnt(0)" ::: "memory");
    const int c = lane & 7;
#pragma unroll
    for (int j = 0; j < 4; ++j) { const int n = (lane >> 3) + 8 * j; const LAS float* s = scr + (8 * c) * 33 + n;
        u32x4 o; o.x = pk2(s[0 * 33], s[1 * 33]); o.y = pk2(s[2 * 33], s[3 * 33]); o.z = pk2(s[4 * 33], s[5 * 33]); o.w = pk2(s[6 * 33], s[7 * 33]);
        *(u32x4*)(WT + (size_t)(drow0 + n) * ldt + k0 + 8 * c) = o; }
    asm volatile("s_waitcnt lgkmcnt(0)" ::: "memory");
}
__device__ __forceinline__ void transpose_mat_item(const float* W, int K, int N, bf16* WT, bool swiglu, int item, LAS float* scr, int lane) {
    const int nblk = N / 32, kb = item / nblk, nb = item % nblk, n0 = 32 * nb; int drow0 = n0;
    if (swiglu) { const int half = N / 2; const int j = (n0 < half) ? n0 : n0 - half; drow0 = (j >> 7) * 256 + ((n0 < half) ? 0 : 128) + (j & 127); }
    transpose_item(W, N, WT, K, 64 * kb, n0, drow0, scr, lane);
}

__device__ __forceinline__ void norm_pass(const float* lat, const float* ctxp, int nrows, const float* g, const float* mod, int sh_i, int sc_i, bf16* dst, float* dstf, int wave, int lane, const float* part = nullptr, const float* pgate = nullptr, int row_begin = 0) {
    const int gw = blockIdx.x * NWAVES + wave, NGW = gridDim.x * NWAVES, nch = nrows >> 2;
    for (int ch = gw + (row_begin >> 2); ch < nch; ch += NGW) {
        const int row0 = ch * 4; const bool isl = row0 < NLAT; const int rix = isl ? (row0 >> 12) : 8;
        const float* src = isl ? lat + (size_t)row0 * D : ctxp + (size_t)(row0 - NLAT) * D;
        f32x4 gs[4], sh[4];
#pragma unroll
        for (int j = 0; j < 4; ++j) { const int col = 4 * lane + 256 * j; gs[j] = *(const f32x4*)(g + col);
            if (mod) { gs[j] = gs[j] * (*(const f32x4*)(mod + (size_t)rix * NMOD + sc_i * D + col) + 1.0f); sh[j] = *(const f32x4*)(mod + (size_t)rix * NMOD + sh_i * D + col); }
            else sh[j] = (f32x4){0.f, 0.f, 0.f, 0.f}; }
#pragma unroll
        for (int rr = 0; rr < 4; ++rr) {
            f32x4 v[4]; float ss = 0.f;
#pragma unroll
            for (int j = 0; j < 4; ++j) { v[j] = __builtin_nontemporal_load((const f32x4*)(src + (size_t)rr * D + 4 * lane + 256 * j));
                if (part && !isl) { const float* pp = part + (size_t)(row0 - NLAT + rr) * D + 4 * lane + 256 * j; const size_t ps = (size_t)2048 * 1024;
                    const f32x4 sp = (*(const f32x4*)pp + *(const f32x4*)(pp + ps)) + (*(const f32x4*)(pp + 2 * ps) + *(const f32x4*)(pp + 3 * ps));
                    v[j] = v[j] + sp * (*(const f32x4*)(pgate + 4 * lane + 256 * j) * 0.5f); }
                ss += (v[j].x * v[j].x + v[j].y * v[j].y) + (v[j].z * v[j].z + v[j].w * v[j].w); }
            const float rstd = 1.0f / sqrtf(wave_sum(ss) * (1.0f / D) + EPS);
#pragma unroll
            for (int j = 0; j < 4; ++j) { const f32x4 o = v[j] * rstd * gs[j] + sh[j]; const size_t off = (size_t)(row0 + rr) * D + 4 * lane + 256 * j;
                if (dstf) __builtin_nontemporal_store(o, (f32x4*)(dstf + off));
                else { u32x2 w; w.x = pk2(o.x, o.y); w.y = pk2(o.z, o.w); *(u32x2*)(dst + off) = w; } }
        }
    }
}

constexpr int PU_STRIDE = 320, PU_ROWS = 144, PO_OFF = PU_ROWS * PU_STRIDE  , PW_OFF = PO_OFF + 128 * 272  ;
__device__ __forceinline__ bf16x8 pfrag(const LAS unsigned char* p) { const s16x4 vl = __builtin_bit_cast(s16x4, __builtin_amdgcn_ds_read_tr16_b64_v4i16((LAS s16x4*)p)), vh = __builtin_bit_cast(s16x4, __builtin_amdgcn_ds_read_tr16_b64_v4i16((LAS s16x4*)(p + 8 * PU_STRIDE)));
    return (bf16x8){vl[0], vl[1], vl[2], vl[3], vh[0], vh[1], vh[2], vh[3]}; }
__device__ __forceinline__ void pool_load(int rb, int gi, const bf16* HX, const bf16* WPt, u32x4 (&v)[5], u32x4 (&wv)[4], int tid) {
    const int b = rb >> 5, t0 = (rb & 31) * 128;
#pragma unroll
    for (int k = 0; k < 5; ++k) { const int cidx = tid + 512 * k, i = cidx >> 4, ch = cidx & 15, t = t0 - 8 + i; v[k] = (u32x4){0u, 0u, 0u, 0u};
        if (cidx < PU_ROWS * 16 && t >= 0 && t < SEQ) v[k] = *(const u32x4*)(HX + (size_t)NTOK * 512 + ((size_t)gi * NTOK + (size_t)b * SEQ + t) * 128 + ch * 8); }
#pragma unroll
    for (int k = 0; k < 4; ++k) { const int cidx = tid + 512 * k; wv[k] = *(const u32x4*)(WPt + (size_t)gi * 128 * 128 + cidx * 8); }
}
__device__ __forceinline__ void pool_stage(LAS unsigned char* lds, const u32x4 (&v)[5], const u32x4 (&wv)[4], int tid) {
#pragma unroll
    for (int k = 0; k < 5; ++k) { const int cidx = tid + 512 * k, i = cidx >> 4, ch = cidx & 15; if (cidx < PU_ROWS * 16) *(LAS u32x4*)(lds + i * PU_STRIDE + ch * 16) = v[k]; }
#pragma unroll
    for (int k = 0; k < 4; ++k) { const int cidx = tid + 512 * k, n = cidx >> 4, ch = cidx & 15; *(LAS u32x4*)(lds + PW_OFF + n * 272 + ch * 16) = wv[k]; }
}
__device__ __forceinline__ void pool_compute(LAS unsigned char* lds, int rb, int gi, const float* pool_scale, bf16* MIX, int tid, int wave, int lane) {
    const int b = rb >> 5, t0 = (rb & 31) * 128, lo = 1 << gi;
    const int r32 = lane & 31, hi = lane >> 5, tb = wave & 3, half = wave >> 2;
    f32x16 acc[4]; acc[0] = f32x16{}; acc[1] = f32x16{}; acc[2] = f32x16{}; acc[3] = f32x16{};
    { const LAS unsigned char* ub = lds + (4 * hi + ((lane & 15) >> 2)) * PU_STRIDE + (16 * ((lane >> 4) & 1) + 4 * (lane & 3)) * 2;
#pragma unroll
      for (int ksl = 0; ksl < 3; ++ksl) { const int ks = 2 * tb + ksl;
          u32x4 bw;
#pragma unroll
          for (int jj = 0; jj < 4; ++jj) { const int j0 = 2 * jj, j1 = 2 * jj + 1;
              const int d0 = 16 * ks + 4 * hi + (j0 & 3) + 8 * (j0 >> 2) - 8 - (32 * tb + r32), d1 = 16 * ks + 4 * hi + (j1 & 3) + 8 * (j1 >> 2) - 8 - (32 * tb + r32);
              bw[jj] = ((d0 >= -lo && d0 < lo) ? 0x3F80u : 0u) | ((d1 >= -lo && d1 < lo) ? 0x3F800000u : 0u); }
          const bf16x8 bfr = __builtin_bit_cast(bf16x8, bw);
#pragma unroll
          for (int cb = 0; cb < 4; ++cb) acc[cb] = __builtin_amdgcn_mfma_f32_32x32x16_bf16(pfrag(ub + ks * 16 * PU_STRIDE + cb * 64), bfr, acc[cb], 0, 0, 0); } }
    bf16x8 dfr[8];
    { const int t = t0 + 32 * tb + r32; const int st = (t - lo > 0) ? t - lo : 0, en = (t + lo - 1 < SEQ - 1) ? t + lo - 1 : SEQ - 1; const float inv = 1.0f / (float)(en - st + 1);
      const LAS unsigned char* own = lds + (32 * tb + r32 + 8) * PU_STRIDE + 8 * hi;
#pragma unroll
      for (int cb = 0; cb < 4; ++cb) { u32x2 dw[4];
#pragma unroll
          for (int g4 = 0; g4 < 4; ++g4) { const u32x2 o2 = *(const LAS u32x2*)(own + (32 * cb + 8 * g4) * 2);
              dw[g4].x = cvtpk(acc[cb][4 * g4] * inv - bflo(o2.x), acc[cb][4 * g4 + 1] * inv - bfhi(o2.x)); dw[g4].y = cvtpk(acc[cb][4 * g4 + 2] * inv - bflo(o2.y), acc[cb][4 * g4 + 3] * inv - bfhi(o2.y)); }
          dfr[2 * cb] = __builtin_bit_cast(bf16x8, (u32x4){dw[0].x, dw[0].y, dw[1].x, dw[1].y}); dfr[2 * cb + 1] = __builtin_bit_cast(bf16x8, (u32x4){dw[2].x, dw[2].y, dw[3].x, dw[3].y}); } }
    f32x16 out[2]; out[0] = f32x16{}; out[1] = f32x16{};
#pragma unroll
    for (int nbl = 0; nbl < 2; ++nbl) { const LAS unsigned char* wrow = lds + PW_OFF + (32 * (2 * half + nbl) + r32) * 272 + 8 * hi;
#pragma unroll
        for (int kq = 0; kq < 8; ++kq) { const u32x2 a0 = *(const LAS u32x2*)(wrow + 32 * kq), a1 = *(const LAS u32x2*)(wrow + 32 * kq + 16);
            out[nbl] = __builtin_amdgcn_mfma_f32_32x32x16_bf16(__builtin_bit_cast(bf16x8, (u32x4){a0.x, a0.y, a1.x, a1.y}), dfr[kq], out[nbl], 0, 0, 0); } }
    { LAS unsigned char* ot = lds + PO_OFF + (32 * tb + r32) * 272;
#pragma unroll
      for (int nbl = 0; nbl < 2; ++nbl)
#pragma unroll
        for (int rq = 0; rq < 4; ++rq) { const int n0 = 32 * (2 * half + nbl) + 8 * rq + 4 * hi; const f32x4 ps = *(const f32x4*)(pool_scale + gi * 128 + n0);
            u32x2 w; w.x = cvtpk(out[nbl][4 * rq] * ps.x, out[nbl][4 * rq + 1] * ps.y); w.y = cvtpk(out[nbl][4 * rq + 2] * ps.z, out[nbl][4 * rq + 3] * ps.w);
            *(LAS u32x2*)(ot + n0 * 2) = w; } }
    __syncthreads();
#pragma unroll
    for (int k = 0; k < 4; ++k) { const int cidx = tid + 512 * k, row = cidx >> 4, ch = cidx & 15;
        *(u32x4*)(MIX + ((size_t)b * SEQ + t0 + row) * D + 512 + gi * 128 + ch * 8) = *(const LAS u32x4*)(lds + PO_OFF + row * 272 + ch * 16); }
}

constexpr int AK_STRIDE = 144, AV_STRIDE = 320, AK_BYTES = 64 * AK_STRIDE, AKS = 2 * AK_BYTES  , AVS = 64 * AV_STRIDE  , AV_BASE = 3 * AKS;
#define SBAR() __builtin_amdgcn_sched_barrier(0)
typedef float f32x2_t __attribute__((ext_vector_type(2))); typedef __bf16 bf16x2_t __attribute__((ext_vector_type(2)));
__device__ __forceinline__ unsigned cvtpk_s(float lo, float hi) { f32x2_t v = {lo, hi}; bf16x2_t bb = __builtin_convertvector(v, bf16x2_t); return __builtin_bit_cast(unsigned, bb); }
__device__ __forceinline__ s16x4 vtr(const LAS unsigned char* p) { return __builtin_bit_cast(s16x4, __builtin_amdgcn_ds_read_tr16_b64_v4i16((LAS s16x4*)p)); }
__device__ __forceinline__ bf16x8 vfrag(const LAS unsigned char* p) { const s16x4 vl = vtr(p), vh = vtr(p + 8 * AV_STRIDE); return (bf16x8){vl[0], vl[1], vl[2], vl[3], vh[0], vh[1], vh[2], vh[3]}; }
__device__ __forceinline__ void glds16(const void* gsrc, unsigned lds_dst) { unsigned keep;
    asm volatile("s_mov_b32 %0, m0\n\ts_mov_b32 m0, %2\n\ts_nop 0\n\tglobal_load_lds_dwordx4 %1, off\n\ts_mov_b32 m0, %0" : "=&s"(keep) : "v"(gsrc), "s"(lds_dst) : "memory"); }
__device__ __forceinline__ float max3f(float a, float b, float c) { float r; asm("v_max3_f32 %0, %1, %2, %3" : "=v"(r) : "v"(a), "v"(b), "v"(c)); return r; }
#define WAIT_BAR0() asm volatile("s_waitcnt vmcnt(0) lgkmcnt(0)\n\ts_barrier" ::: "memory")
#define WAIT_BAR5() asm volatile("s_waitcnt vmcnt(5) lgkmcnt(0)\n\ts_barrier" ::: "memory")
template <int MODE> __device__ __forceinline__ void attn_unit(LAS unsigned char* lds, int b, int h, int qb, const bf16* HQ, const bf16* KP, const bf16* VP, bf16* MIX, const float* g_sub, float lam, int tid, int wave, int lane) {
    const int r32 = lane & 31, hi = lane >> 5, map = wave >> 2, qw = wave & 3;
    const size_t qrow = (size_t)b * SEQ + qb * 128 + qw * 32 + r32;
    bf16x8 qf[4];
#pragma unroll
    for (int d0 = 0; d0 < 4; ++d0) qf[d0] = *(const bf16x8*)(HQ + qrow * 512 + h * 128 + map * 64 + d0 * 16 + hi * 8);
    unsigned soff[5], ldst[5]; bool isv[5], valid[5];
#pragma unroll
    for (int i = 0; i < 5; ++i) { const int bid = wave + 8 * i; valid[i] = bid < 38; isv[i] = bid >= 18;
        if (bid < 18) { const int km = bid / 9, j = bid % 9, p = 64 * j + lane, row = p / 9; int ch = p % 9; if (ch == 8) ch = 0;
            soff[i] = (unsigned)(row * 128 + km * 64 + ch * 8) * 2u; ldst[i] = km * AK_BYTES + j * 1024; }
        else { const int j = bid - 18, p = 64 * j + lane, row = p / 20; int ch = p % 20; if (ch >= 16) ch = 0;
            soff[i] = (unsigned)(row * 128 + ch * 8) * 2u; ldst[i] = j * 1024; } }
    if (!valid[4]) { soff[4] = soff[0]; ldst[4] = ldst[0]; isv[4] = isv[0]; valid[4] = true; }
    const unsigned lds0 = (unsigned)(uintptr_t)lds;
    const char* kbase = (const char*)(KP + (size_t)(b * 4 + h) * 4352 * 128); const char* vbase = (const char*)(VP + (size_t)(b * 4 + h) * 4352 * 128);
#define DMA_I(i, tk, sk, tv, sv, dok, dov) do { if (!(MODE & 2) && (isv[i] ? (dov) : (dok))) { const int tt_ = isv[i] ? (tv) : (tk); \
        glds16((isv[i] ? vbase : kbase) + (size_t)tt_ * 16384 + soff[i], (unsigned)__builtin_amdgcn_readfirstlane(lds0 + (isv[i] ? AV_BASE + (sv) * AVS : (sk) * AKS) + ldst[i])); } } while (0)
#define DMA_KV(tk, sk, tv, sv, dok, dov) do { DMA_I(0, tk, sk, tv, sv, dok, dov); DMA_I(1, tk, sk, tv, sv, dok, dov); DMA_I(2, tk, sk, tv, sv, dok, dov); DMA_I(3, tk, sk, tv, sv, dok, dov); DMA_I(4, tk, sk, tv, sv, dok, dov); } while (0)
    constexpr int NT = (SEQ + CTX) / 64;
    DMA_KV(0, 0, 0, 0, true, false);
    DMA_KV(1, 1, 0, 0, true, true);
    WAIT_BAR5();
    f32x16 o[4]; o[0] = f32x16{}; o[1] = f32x16{}; o[2] = f32x16{}; o[3] = f32x16{};
    const f32x16 zero16 = f32x16{};
    float mrun = -INFINITY, lrun = 0.f;
    const unsigned koff = map * AK_BYTES + r32 * AK_STRIDE + hi * 16;
    const unsigned voff = AV_BASE + (4 * hi + ((lane & 15) >> 2)) * AV_STRIDE + (16 * ((lane >> 4) & 1) + 4 * (lane & 3)) * 2;
    u32x4 pw[4];
    f32x16 X0, X1;
#define KFR(i) (*(const LAS bf16x8*)(kb_ + (1 - ((i) >> 2)) * 32 * AK_STRIDE + ((i) & 3) * 32))
#define VFR(i) vfrag(vb_ + ((i) >> 2) * 16 * AV_STRIDE + ((i) & 3) * 64)
#define GAPA(i, HASP) do { if ((i) + 3 < 8) kr[((i) + 3) & 3] = KFR((i) + 3); \
        if ((i) < 4) { X1 = __builtin_amdgcn_mfma_f32_32x32x16_bf16(kr[(i) & 3], qf[(i) & 3], ((i) & 3) ? X1 : zero16, 0, 0, 0); \
            if (HASP) { sacc += (X0[(4 * (i)) & 15] + X0[(4 * (i) + 1) & 15]) + (X0[(4 * (i) + 2) & 15] + X0[(4 * (i) + 3) & 15]); \
                pw[((i) >> 1) & 1][((i) & 1) * 2] = cvtpk_s(X0[(4 * (i)) & 15], X0[(4 * (i) + 1) & 15]); pw[((i) >> 1) & 1][((i) & 1) * 2 + 1] = cvtpk_s(X0[(4 * (i) + 2) & 15], X0[(4 * (i) + 3) & 15]); asm volatile("" : "+v"(sacc)); } } \
        else X0 = __builtin_amdgcn_mfma_f32_32x32x16_bf16(kr[(i) & 3], qf[(i) & 3], ((i) & 3) ? X0 : zero16, 0, 0, 0); \
        SBAR(); } while (0)
#define EXC_(v) do { if (MODE & 1) break; if ((v) < 16) X0[(v) & 15] = __builtin_amdgcn_exp2f(X0[(v) & 15] - mrun); else X1[(v) & 15] = __builtin_amdgcn_exp2f(X1[(v) & 15] - mrun); } while (0)
#define GAPB(i, HASP) do { if ((HASP) && !(MODE & 4)) { if ((i) + 3 < 16) vr[((i) + 3) & 3] = VFR((i) + 3); \
            o[(i) & 3] = __builtin_amdgcn_mfma_f32_32x32x16_bf16(vr[(i) & 3], __builtin_bit_cast(bf16x8, pw[(i) >> 2]), o[(i) & 3], 0, 0, 0); } \
        EXC_(2 * (i)); EXC_(2 * (i) + 1); if ((i) < 8) asm volatile("" : "+v"(X0)); else asm volatile("" : "+v"(X1)); SBAR(); } while (0)
#define STEP(t, s0, HASP, DOK, DOV, WAITB) do { \
        const int s1_ = ((s0) == 2) ? 0 : (s0) + 1, s2_ = ((s0) == 0) ? 2 : (s0) - 1;     \
        const LAS unsigned char* kb_ = lds + (s0) * AKS + koff; const LAS unsigned char* vb_ = lds + s2_ * AVS + voff; \
        DMA_KV((t) + 2, s2_, (t) + 1, s1_, DOK, DOV); \
        bf16x8 kr[4]; kr[0] = KFR(0); kr[1] = KFR(1); kr[2] = KFR(2); float sacc = 0.f; SBAR(); \
        GAPA(0, HASP); GAPA(1, HASP); GAPA(2, HASP); GAPA(3, HASP); GAPA(4, HASP); GAPA(5, HASP); GAPA(6, HASP); GAPA(7, HASP); \
        lrun += sacc; \
        bf16x8 vr[4]; if ((HASP) && !(MODE & 4)) { vr[0] = VFR(0); vr[1] = VFR(1); vr[2] = VFR(2); } \
        float mx = fmaxf(X0[0], X1[0]); \
        if (!(MODE & 1)) { _Pragma("unroll") for (int r_ = 1; r_ < 16; ++r_) mx = max3f(mx, X0[r_], X1[r_]); } \
        { auto rr_ = __builtin_amdgcn_permlane32_swap(__float_as_uint(mx), __float_as_uint(mx), false, false); mx = max3f(mx, __uint_as_float(rr_[0]), __uint_as_float(rr_[1])); } \
        const bool resc = __any(mx > mrun); const float mn = max3f(mrun, mrun, mx), fsc = __builtin_amdgcn_exp2f(mrun - mn); lrun *= fsc; mrun = mn;     \
        SBAR(); \
        GAPB(0, HASP); GAPB(1, HASP); GAPB(2, HASP); GAPB(3, HASP); GAPB(4, HASP); GAPB(5, HASP); GAPB(6, HASP); GAPB(7, HASP); \
        GAPB(8, HASP); GAPB(9, HASP); GAPB(10, HASP); GAPB(11, HASP); GAPB(12, HASP); GAPB(13, HASP); GAPB(14, HASP); GAPB(15, HASP); \
        if (resc) { _Pragma("unroll") for (int db_ = 0; db_ < 4; ++db_) o[db_] = o[db_] * fsc; } \
        { float st_ = 0.f; _Pragma("unroll") for (int r_ = 0; r_ < 16; ++r_) st_ += X1[r_]; lrun += st_; \
          pw[2] = (u32x4){cvtpk_s(X1[0], X1[1]), cvtpk_s(X1[2], X1[3]), cvtpk_s(X1[4], X1[5]), cvtpk_s(X1[6], X1[7])}; \
          pw[3] = (u32x4){cvtpk_s(X1[8], X1[9]), cvtpk_s(X1[10], X1[11]), cvtpk_s(X1[12], X1[13]), cvtpk_s(X1[14], X1[15])}; } \
        WAITB(); } while (0)
    STEP(0, 0, false, true, true, WAIT_BAR5);
    { int s0 = 1;
      for (int t = 1; t < NT - 2; ++t) { STEP(t, s0, true, true, true, WAIT_BAR5); s0 = (s0 == 2) ? 0 : s0 + 1; } }
    STEP(NT - 2, (NT - 2) % 3, true, false, true, WAIT_BAR0);
    STEP(NT - 1, (NT - 1) % 3, true, false, false, WAIT_BAR0);
    { float sacc = 0.f;
#pragma unroll
      for (int r = 0; r < 16; ++r) sacc += X0[r];
      lrun += sacc;
      pw[0] = (u32x4){cvtpk_s(X0[0], X0[1]), cvtpk_s(X0[2], X0[3]), cvtpk_s(X0[4], X0[5]), cvtpk_s(X0[6], X0[7])};
      pw[1] = (u32x4){cvtpk_s(X0[8], X0[9]), cvtpk_s(X0[10], X0[11]), cvtpk_s(X0[12], X0[13]), cvtpk_s(X0[14], X0[15])};
      const LAS unsigned char* vb_ = lds + ((NT - 1) % 3) * AVS + voff;
#pragma unroll
      for (int i = 0; i < 16; ++i) o[i & 3] = __builtin_amdgcn_mfma_f32_32x32x16_bf16(VFR(i), __builtin_bit_cast(bf16x8, pw[i >> 2]), o[i & 3], 0, 0, 0);
    }
    __syncthreads();
#undef DMA_I
#undef DMA_KV
#undef KFR
#undef VFR
#undef GAPA
#undef EXC_
#undef GAPB
#undef STEP
    lrun += __shfl_xor(lrun, 32);
    const float rl = 1.0f / lrun;
    LAS float* ex = (LAS float*)lds + qw * 4096;
    if (map == 1) {
#pragma unroll
        for (int db = 0; db < 4; ++db)
#pragma unroll
            for (int r = 0; r < 16; ++r) ex[(db * 16 + r) * 64 + lane] = o[db][r] * rl;
    }
    __syncthreads();
    if (map == 0) {
        float ss = 0.f;
#pragma unroll
        for (int db = 0; db < 4; ++db)
#pragma unroll
            for (int r = 0; r < 16; ++r) { const float v = o[db][r] * rl - lam * ex[(db * 16 + r) * 64 + lane]; o[db][r] = v; ss += v * v; }
        ss += __shfl_xor(ss, 32);
        const float rstd = (1.0f - LAM_INIT) / sqrtf(ss * (1.0f / 128.0f) + EPS);
        bf16* op = MIX + qrow * D + h * 128;
#pragma unroll
        for (int db = 0; db < 4; ++db)
#pragma unroll
            for (int rq = 0; rq < 4; ++rq) { const int d0 = 32 * db + 8 * rq + 4 * hi; const f32x4 gsv = *(const LAS f32x4*)(lds + 131072 + 2048 + d0 * 4);
                u32x2 w; w.x = cvtpk(o[db][4 * rq] * rstd * gsv.x, o[db][4 * rq + 1] * rstd * gsv.y); w.y = cvtpk(o[db][4 * rq + 2] * rstd * gsv.z, o[db][4 * rq + 3] * rstd * gsv.w);
                *(u32x2*)(op + d0) = w; }
    }
    __syncthreads();
}
#undef SBAR

#define XB_TMO      128
#define XB_XCNT(j)  (256  + 64 * (j))
#define XB_XSUB(j)  (1280 + 64 * (j))
#define XB_XGEN(j)  (2304 + 64 * (j))
#define XB_TOP      3328
#define XB_TOPGEN   3392
#define XCD_BAR_WORDS 3456
#define XB_SPIN_CAP (1u << 18)

__device__ __forceinline__ unsigned xb_ld(unsigned* p)              { return __hip_atomic_load(p, __ATOMIC_RELAXED, __HIP_MEMORY_SCOPE_AGENT); }
__device__ __forceinline__ unsigned xb_add(unsigned* p, unsigned v) { return __hip_atomic_fetch_add(p, v, __ATOMIC_RELAXED, __HIP_MEMORY_SCOPE_AGENT); }
__device__ __forceinline__ unsigned xb_xcc_id() { return (unsigned)__builtin_amdgcn_s_getreg((3 << 11) | 20) & 0xFu; }
#define XB_SPIN(cond, bar) do { unsigned _sp = 0; while (cond) { __builtin_amdgcn_s_sleep(1); \
    if ((++_sp & 255u) == 0u) { if (xb_ld(&(bar)[XB_TMO])) break; if (_sp > XB_SPIN_CAP) { atomicAdd(&(bar)[XB_TMO], 1u); break; } } } } while (0)

struct XcdBarrier {
    unsigned* bar; unsigned x;
    volatile LAS unsigned* st;
};

__device__ __forceinline__ XcdBarrier xcd_barrier_post(unsigned* bar, volatile LAS unsigned* st) {
    XcdBarrier b; b.bar = bar; b.x = xb_xcc_id(); b.st = st;
    if (threadIdx.x == 0) (void)xb_add(&bar[XB_XCNT(b.x)], 1u);
    return b;
}
__device__ __forceinline__ void xcd_barrier_complete(unsigned* bar, unsigned x, unsigned& nloc, unsigned& nx) {
    const unsigned G = gridDim.x * gridDim.y * gridDim.z;
    unsigned sum, cnt, mine, sp = 0u;
    for (;;) {
        sum = 0u; cnt = 0u; mine = 0u;
#pragma unroll
        for (unsigned j = 0; j < 16; ++j) { const unsigned c = xb_ld(&bar[XB_XCNT(j)]); sum += c; cnt += (c > 0u) ? 1u : 0u; mine = (j == x) ? c : mine; }
        if (sum == G) break;
        __builtin_amdgcn_s_sleep(1);
        if ((++sp & 255u) == 0u) { if (xb_ld(&bar[XB_TMO])) break; if (sp > XB_SPIN_CAP) { atomicAdd(&bar[XB_TMO], 1u); break; } }
    }
    nloc = mine > 0u ? mine : 1u; nx = cnt > 0u ? cnt : 1u;
}

__device__ __forceinline__ void xcd_barrier(const XcdBarrier& b) {
    asm volatile("s_waitcnt vmcnt(0)" ::: "memory");
    __syncthreads();
    if (threadIdx.x == 0) {
        unsigned* bar = b.bar;
        __builtin_amdgcn_s_waitcnt(0);
        unsigned nloc = b.st[0], nx = b.st[1];
        if (nloc == 0u) { xcd_barrier_complete(bar, b.x, nloc, nx); b.st[0] = nloc; b.st[1] = nx; }
        const unsigned old = xb_add(&bar[XB_XSUB(b.x)], 1u);
        const unsigned gen = old / nloc;
        if (old + 1u == (gen + 1u) * nloc) {
            __builtin_amdgcn_fence(__ATOMIC_RELEASE, "agent");
            asm volatile("s_waitcnt vmcnt(0)" ::: "memory");
            const unsigned og = xb_add(&bar[XB_TOP], 1u);
            const unsigned tg = og / nx;
            if (og + 1u == (tg + 1u) * nx) xb_add(&bar[XB_TOPGEN], 1u);
            else XB_SPIN(xb_ld(&bar[XB_TOPGEN]) == tg, bar);
            __builtin_amdgcn_fence(__ATOMIC_ACQUIRE, "agent");
            xb_add(&bar[XB_XGEN(b.x)], 1u);
            asm volatile("s_waitcnt vmcnt(0)" ::: "memory");
        } else {
            XB_SPIN(xb_ld(&bar[XB_XGEN(b.x)]) == gen, bar);
            __builtin_amdgcn_fence(__ATOMIC_ACQUIRE, "agent");
            asm volatile("s_waitcnt vmcnt(0)" ::: "memory");
        }
    }
    __syncthreads();
}

struct Args { const float* in[23]; float* out; unsigned char* ws; int ph_lo, ph_hi; };
__global__ void __launch_bounds__(NWAVES * 64, 2) mk_fwd(Args a) {
    extern __shared__ __attribute__((aligned(16))) unsigned char lds_raw[];
    LAS unsigned char* lds = (LAS unsigned char*)lds_raw;
    const int tid = threadIdx.x, lane = tid & 63, wave = __builtin_amdgcn_readfirstlane(tid >> 6), G = gridDim.x, bx = blockIdx.x;
    unsigned char* ws = a.ws;
    const float *x = a.in[0], *c = a.in[1], *ctx = a.in[2], *c_ctx = a.in[3], *w_mod = a.in[4], *b_mod = a.in[5], *g_ffn1 = a.in[6], *ffn1_w_in = a.in[7], *ffn1_w_out = a.in[8],
                *g_mix = a.in[9], *w_in = a.in[10], *lq1 = a.in[11], *lk1 = a.in[12], *lq2 = a.in[13], *lk2 = a.in[14], *g_sub = a.in[15], *w_pool = a.in[16], *pool_scale = a.in[17],
                *w_out = a.in[18], *g_ffn2 = a.in[19], *ffn2_w_in = a.in[20], *ffn2_w_out = a.in[21], *g_final = a.in[22];
    float* mod = (float*)(ws + WS_MOD);
    bf16 *W1A = (bf16*)(ws + WS_W1A), *W2A = (bf16*)(ws + WS_W2A), *W1B = (bf16*)(ws + WS_W1B), *W2B = (bf16*)(ws + WS_W2B), *WINt = (bf16*)(ws + WS_WIN), *WOUTt = (bf16*)(ws + WS_WOUT), *WPt = (bf16*)(ws + WS_WP);
    bf16 *HN = (bf16*)(ws + WS_HN), *MIX = (bf16*)(ws + WS_HN), *ACT = (bf16*)(ws + WS_BIG), *HX = (bf16*)(ws + WS_BIG)  , *KP = (bf16*)(ws + WS_BIG + 68 * MiB), *VP = (bf16*)(ws + WS_BIG + 102 * MiB);
    float* X1 = (float*)(ws + WS_X1);
    float* xpart = (float*)(ws + 44 * MiB); unsigned* xcnt = (unsigned*)(ws + 700 * 1024);
    constexpr int I1 = (D / 64) * (2 * DFF / 32), I2 = (DFF / 64) * (D / 32), I3 = (D / 64) * (INW / 32), I4 = (D / 64) * (D / 32), I5 = 4 * 2 * 4;
#define CONV_RANGE(ilo, ihi, first_wg) do { const int fw_ = ((first_wg) < G) ? (first_wg) : 0; if (bx >= fw_) { LAS float* scr = (LAS float*)(lds + wave * 16384); \
        for (int it = (ilo) + (bx - fw_) * NWAVES + wave; it < (ihi); it += (G - fw_) * NWAVES) { int r = it; \
            if (r < I1) { transpose_mat_item(ffn1_w_in, D, 2 * DFF, W1A, true, r, scr, lane); continue; } r -= I1; \
            if (r < I1) { transpose_mat_item(ffn2_w_in, D, 2 * DFF, W1B, true, r, scr, lane); continue; } r -= I1; \
            if (r < I2) { transpose_mat_item(ffn1_w_out, DFF, D, W2A, false, r, scr, lane); continue; } r -= I2; \
            if (r < I2) { transpose_mat_item(ffn2_w_out, DFF, D, W2B, false, r, scr, lane); continue; } r -= I2; \
            if (r < I3) { transpose_mat_item(w_in, D, INW, WINt, false, r, scr, lane); continue; } r -= I3; \
            if (r < I4) { transpose_mat_item(w_out, D, D, WOUTt, false, r, scr, lane); continue; } r -= I4; \
            { const int gi = r >> 3; transpose_mat_item(w_pool + (size_t)gi * 128 * 128, 128, 128, WPt + (size_t)gi * 128 * 128, false, r & 7, scr, lane); } } } } while (0)
    const int lo = a.ph_lo, hi = a.ph_hi;
#define IN(k) (lo <= (k) && (k) < hi)
#define SEAM(k) do { if (IN(k) && IN((k) + 1)) xcd_barrier(bar); } while (0)

    if (tid < 4) ((volatile LAS unsigned*)(lds + 131072 + 64))[tid] = 0u;
    __syncthreads();
    if (IN(0)) {
        if (bx == 0) for (int i = tid; i < XCD_BAR_WORDS; i += 512) ((unsigned*)(ws + WS_BAR))[i] = 0u;
        for (int i = bx * 512 + tid; i < 3 * 128 * 64; i += G * 512) xcnt[i] = 0u;
        for (int u = bx; u < 144; u += G) adaln_unit(lds, u, c, c_ctx, w_mod, b_mod, mod, tid);
        CONV_RANGE(0, I1, 0); CONV_RANGE(2 * I1, 2 * I1 + I2, 0);
    }
    XcdBarrier bar; bar.bar = (unsigned*)(ws + WS_BAR); bar.x = 0; bar.st = nullptr;
    if (IN(0) && IN(1)) {
        cg::this_grid().sync();
        bar.bar = (unsigned*)(ws + WS_BAR); bar.x = xb_xcc_id(); bar.st = (volatile LAS unsigned*)(lds + 131072 + 64);
        if (tid == 0) bar.st[2] = xb_add(&bar.bar[XB_XCNT(bar.x)], 1u);
    }
    if (IN(1)) norm_pass(x, ctx, NTOK, g_ffn1, mod, 0, 1, HN, nullptr, wave, lane);
    SEAM(1);
    if (IN(2)) { pg8::Gemm g{HN, W1A, NTOK, 2 * DFF, D}; pg8::StaticOrder S; S.init(NTOK, 2 * DFF, G, bx, D); pg8::EpiSwiglu E{ACT, DFF};
        pg8::gemm_phase<pg8::EpiSwiglu, pg8::StaticOrder, true, true>(lds, g, S, E);
        CONV_RANGE(2 * I1 + 2 * I2, 2 * I1 + 2 * I2 + I3 + I4 + I5, ((NTOK / 256) * (2 * DFF / 256)) % G); }
    SEAM(2);
    if (IN(3)) { pg8::Gemm g{ACT, W2A, NTOK, D, DFF};
        { pg8::StaticOrder S; S.init(NLAT, D, G, bx, DFF);
          pg8::EpiResidRms<1, false> E{x, X1, mod + 2 * D, g_mix, mod + 4 * D, mod + 3 * D, HN, xpart, xcnt, (PG8_LAS float*)(lds + 131072 + 1024), nullptr};
          pg8::gemm_phase<pg8::EpiResidRms<1, false>, pg8::StaticOrder, true, true>(lds, g, S, E); }
        { pg8::SplitOnlyOrder S; S.init(NLAT, G, bx);
          pg8::EpiSplitRaw E{a.out};
          pg8::gemm_phase<pg8::EpiSplitRaw, pg8::SplitOnlyOrder, true, true>(lds, g, S, E); }
        CONV_RANGE(2 * I1 + I2, 2 * I1 + 2 * I2, 128); }
    SEAM(3);
    if (IN(4)) norm_pass(X1, ctx, NTOK, g_mix, mod, 3, 4, HN, nullptr, wave, lane, a.out, mod + (size_t)8 * NMOD + 2 * D, NLAT);
    SEAM(4);
    if (IN(5)) { pg8::Gemm g{HN, WINt, NTOK, INW, D}; pg8::StaticOrder S; S.init(NTOK, INW, G, bx, D); pg8::EpiInproj E{HX, KP, VP, QSCALE};
        pg8::gemm_phase<pg8::EpiInproj, pg8::StaticOrder, true, true>(lds, g, S, E);
        CONV_RANGE(I1, 2 * I1, ((NTOK / 256) * (INW / 256)) % G); }
    SEAM(5);
    if (IN(6)) {
        { u32x4 pv[5], pw_[4]; int u = bx;
          if (u < 1024) pool_load(u >> 2, (u + (u >> 8)) & 3, HX, WPt, pv, pw_, tid);
          for (; u < 1024; u += G) { pool_stage(lds, pv, pw_, tid); __syncthreads();
              const int un = u + G; if (un < 1024) pool_load(un >> 2, (un + (un >> 8)) & 3, HX, WPt, pv, pw_, tid);
              pool_compute(lds, u >> 2, (u + (u >> 8)) & 3, pool_scale, MIX, tid, wave, lane); } }
        __syncthreads();
        float d1 = 0.f, d2 = 0.f;
        for (int i = 0; i < 64; ++i) { d1 += lq1[i] * lk1[i]; d2 += lq2[i] * lk2[i]; }
        if (tid < 128) ((LAS float*)(lds + 131072 + 2048))[tid] = g_sub[tid];
        const float lam = __expf(d1) - __expf(d2) + LAM_INIT;
        int xcd = bx & 7, j = bx >> 3;
        if (IN(0)) {
            bool okc = (G == 256);
            for (int q = 0; q < 8; ++q) okc = okc && (xb_ld(&bar.bar[XB_XCNT(q)]) == 32u);
            if (okc && bar.x < 8u) { xcd = (int)bar.x; j = (int)((volatile LAS unsigned*)(lds + 131072 + 64))[2]; }
        }
        for (int u = j; u < 128; u += (G >> 3)) { const int bh = 4 * xcd + (u >> 5), qb = u & 31; attn_unit<0>(lds, bh >> 2, bh & 3, qb, HX, KP, VP, MIX, g_sub, lam, tid, wave, lane); }
    }
    SEAM(6);
    if (IN(7)) { pg8::Gemm g{MIX, WOUTt, NLAT, D, D}; pg8::StaticOrder S; S.init(NLAT, D, G, bx, D);
        pg8::EpiResidRms<2, false> E{X1, X1, mod + 5 * D, g_ffn2, mod + 7 * D, mod + 6 * D, (bf16*)a.out, xpart, xcnt + 1 * 128 * 64, (PG8_LAS float*)(lds + 131072 + 1024), nullptr};
        pg8::gemm_phase<pg8::EpiResidRms<2, false>, pg8::StaticOrder, true, true>(lds, g, S, E); }
    SEAM(7);
    if (IN(9)) { pg8::Gemm g{(const bf16*)a.out, W1B, NLAT, 2 * DFF, D}; pg8::StaticOrder S; S.init(NLAT, 2 * DFF, G, bx, D); pg8::EpiSwiglu E{ACT, DFF};
        pg8::gemm_phase<pg8::EpiSwiglu, pg8::StaticOrder, true, true>(lds, g, S, E); }
    SEAM(9);
    if (IN(10)) { pg8::Gemm g{ACT, W2B, NLAT, D, DFF}; pg8::StaticOrder S; S.init(NLAT, D, G, bx, DFF);
        pg8::EpiResidRms<1, true> E{X1, a.out, mod + 8 * D, g_final, nullptr, nullptr, nullptr, xpart, xcnt + 2 * 128 * 64, (PG8_LAS float*)(lds + 131072 + 1024), nullptr};
        pg8::gemm_phase<pg8::EpiResidRms<1, true>, pg8::StaticOrder, true, true>(lds, g, S, E); }
#undef IN
#undef CONV_RANGE
#undef SEAM
}

extern "C" void kernel_launch(void* const* d_in, const int* in_sizes, int n_in, void* d_out, int out_size, void* d_ws, size_t ws_size, hipStream_t stream) {
    static int grid = 0;
    if (grid == 0) {
        if (n_in != 23 || in_sizes[0] != NLAT * D || out_size != NLAT * D || ws_size < WS_END) { fprintf(stderr, "kernel_launch: unexpected shapes (n_in %d, in0 %d, out %d, ws %zu)\n", n_in, n_in > 0 ? in_sizes[0] : -1, out_size, ws_size); grid = -1; return; }
        int dev = 0, cus = 0, per_cu = 0;
        if (hipGetDevice(&dev) != hipSuccess || hipDeviceGetAttribute(&cus, hipDeviceAttributeMultiprocessorCount, dev) != hipSuccess) { grid = -1; return; }
        if (hipFuncSetAttribute((const void*)mk_fwd, hipFuncAttributeMaxDynamicSharedMemorySize, LDS_BYTES) != hipSuccess) { fprintf(stderr, "kernel_launch: hipFuncSetAttribute failed\n"); grid = -1; return; }
        if (hipOccupancyMaxActiveBlocksPerMultiprocessor(&per_cu, (const void*)mk_fwd, NWAVES * 64, LDS_BYTES) != hipSuccess || per_cu < 1) { fprintf(stderr, "kernel_launch: occupancy query says %d blocks/CU\n", per_cu); grid = -1; (void)hipGetLastError(); return; }
        grid = cus;
    }
    if (grid < 0) return;
    Args a{};
    for (int i = 0; i < 23; ++i) a.in[i] = (const float*)d_in[i];
    a.out = (float*)d_out; a.ws = (unsigned char*)d_ws;
#if MK_N_LAUNCHES == 1
    a.ph_lo = 0; a.ph_hi = NPHASE;
    void* args[] = {&a};
    hipError_t e = hipLaunchCooperativeKernel((const void*)mk_fwd, dim3(grid), dim3(NWAVES * 64), args, LDS_BYTES, stream);
    if (e != hipSuccess) fprintf(stderr, "kernel_launch: cooperative launch failed: %s (grid %d)\n", hipGetErrorString(e), grid);
#else
    for (int p = 0; p < NPHASE; ++p) { a.ph_lo = p; a.ph_hi = p + 1; hipLaunchKernelGGL(mk_fwd, dim3(grid), dim3(NWAVES * 64), LDS_BYTES, stream, a); }
#endif
}
```

```cpp
#include <hip/hip_runtime.h>
#include <cstdio>
#include <cstdint>
#include <cmath>
namespace pg8 {
#define PG8_LAS __attribute__((address_space(3)))
typedef unsigned short bf16_t;
typedef short bf16x8 __attribute__((ext_vector_type(8)));
typedef float f32x4 __attribute__((ext_vector_type(4)));
typedef unsigned u32x4 __attribute__((ext_vector_type(4)));
constexpr int BM = 256, BK = 64, HALF = 128, HTB = HALF * BK * 2  , STAGE_BYTES = 8 * HTB, NXCD = 8, WGM = 8;

__host__ __device__ __forceinline__ int lds_byte(int r, int c) { const int st = (r >> 4) * 2 + (c >> 5), rr = r & 15, cc = c & 31, ob = rr * 64 + cc * 2; return st * 1024 + (ob ^ (((ob >> 9) & 1) << 5)); }
__host__ __device__ __forceinline__ void stage_rc(int b, int& R, int& C) { const int st = b / 1024, sb = b % 1024, swz = sb ^ (((sb >> 9) & 1) << 5); R = (st >> 1) * 16 + swz / 64; C = (st & 1) * 32 + (swz % 64) / 2; }
__host__ __device__ __forceinline__ int perm32(int rho) { const int n = rho >> 4, i = rho & 15; return 8 * (i >> 2) + 4 * n + (i & 3); }

struct Unit { int pm, pn, kt0, nk; };
struct Gemm { const bf16_t* A; const bf16_t* Bt; int M, N, K; };

struct StaticOrder {
    int nM, nN, nwg, G, c, nkt;
    __host__ __device__ void init(int M, int N, int G_, int c_, int K_) { nM = M / BM; nN = N / BM; nwg = nM * nN; G = G_; c = c_; nkt = K_ / BK; }
    __host__ __device__ bool next(int i, Unit& u) const {
        const long L = (long)i * G + c; if (L >= nwg) return false;
        int wgid = (int)L; { const int q = nwg / NXCD, r = nwg % NXCD, xcd = wgid % NXCD, off = wgid / NXCD; wgid = (xcd < r ? xcd * (q + 1) : r * (q + 1) + (xcd - r) * q) + off; }
        const int nig = WGM * nN, gid = wgid / nig, fm = gid * WGM, gsz = (nM - fm) < WGM ? (nM - fm) : WGM;
        u.pm = fm + ((wgid % nig) % gsz); u.pn = (wgid % nig) / gsz; u.kt0 = 0; u.nk = nkt; return true;
    }
    __device__ __forceinline__ void a_ready(const Unit&) const {}
    __device__ __forceinline__ void done(const Unit&) const {}
};

struct SplitOrder {
    StaticOrder S; int nfull, G, c;
    __host__ __device__ void init(int Mlat, int N, int G_, int c_, int K_) { S.init(Mlat, N, G_, c_, K_); nfull = S.nwg; G = G_; c = c_; }
    __host__ __device__ bool next(int i, Unit& u) const {
        const long L = (long)i * G + c;
        if (L < nfull) return S.next(i, u);
        const int idx = (int)(L - nfull); if (idx >= 128) return false;
        const int un = idx >> 2, s = idx & 3; u.pm = S.nM + (un >> 2); u.pn = un & 3; u.kt0 = 12 * s; u.nk = (s == 3) ? 8 : 12; return true;
    }
    __device__ __forceinline__ void a_ready(const Unit&) const {}
    __device__ __forceinline__ void done(const Unit&) const {}
};
struct SplitOnlyOrder {
    int nMlat, G, c;
    __host__ __device__ void init(int Mlat, int G_, int c_) { nMlat = Mlat / BM; G = G_; c = c_; }
    __host__ __device__ bool next(int i, Unit& u) const {
        const long L = (long)i * G + c; if (L >= 128) return false;
        const int idx = (int)L, un = idx >> 2, s = idx & 3; u.pm = nMlat + (un >> 2); u.pn = un & 3; u.kt0 = 12 * s; u.nk = (s == 3) ? 8 : 12; return true;
    }
    __device__ __forceinline__ void a_ready(const Unit&) const {}
    __device__ __forceinline__ void done(const Unit&) const {}
};
__device__ __forceinline__ unsigned cvt_pk_bf16(float lo, float hi) { unsigned r; asm volatile("v_cvt_pk_bf16_f32 %0, %1, %2" : "=v"(r) : "v"(lo), "v"(hi)); return r; }
typedef float f32x2 __attribute__((ext_vector_type(2)));
__device__ __forceinline__ f32x2 gelu_pk(f32x2 v) {
    const f32x2 av = __builtin_elementwise_abs(v), d = av * 0.2316418882f + 1.0f;
    f32x2 t; t.x = __builtin_amdgcn_rcpf(d.x); t.y = __builtin_amdgcn_rcpf(d.y);
    f32x2 q = t * 0.5307027145f + (-0.7265760135f); q = q * t + 0.7107068705f; q = q * t + (-0.142248368f); q = q * t + 0.127414796f; q = q * t;
    const f32x2 s = (v * v) * (-0.72134752044f);
    f32x2 e; e.x = __builtin_amdgcn_exp2f(s.x); e.y = __builtin_amdgcn_exp2f(s.y);
    const f32x2 m = v * (q * e), r = v - m;
    f32x2 o; o.x = v.x < 0.f ? m.x : r.x; o.y = v.y < 0.f ? m.y : r.y; return o;
}

typedef unsigned u32x2 __attribute__((ext_vector_type(2)));
__device__ __forceinline__ float silu_f(float g) { return g * __builtin_amdgcn_rcpf(1.0f + __builtin_amdgcn_exp2f(-1.4426950408889634f * g)); }
struct EpiSwiglu {
    static constexpr bool PERM = true, AFTER_DRAIN = false;
    bf16_t* O; int ldo;
    __device__ __forceinline__ void operator()(const f32x4 (&acc)[2][2][4][2], const Unit& u, int wr, int wc, int fr, int fq) const {
        const int row0 = u.pm * BM + wr * 64 + fr, col0 = u.pn * HALF + wc * 32 + 8 * fq;
#pragma unroll
        for (int ai = 0; ai < 2; ++ai)
#pragma unroll
            for (int m = 0; m < 4; ++m) {
                bf16_t* p = O + (size_t)(row0 + ai * HALF + m * 16) * ldo + col0;
                const f32x4 g0 = acc[ai][0][m][0], g1 = acc[ai][0][m][1], u0 = acc[ai][1][m][0], u1 = acc[ai][1][m][1];
                u32x4 w;
                w.x = cvt_pk_bf16(silu_f(g0[0]) * u0[0], silu_f(g0[1]) * u0[1]); w.y = cvt_pk_bf16(silu_f(g0[2]) * u0[2], silu_f(g0[3]) * u0[3]);
                w.z = cvt_pk_bf16(silu_f(g1[0]) * u1[0], silu_f(g1[1]) * u1[1]); w.w = cvt_pk_bf16(silu_f(g1[2]) * u1[2], silu_f(g1[3]) * u1[3]);
                __builtin_nontemporal_store(w, (u32x4*)p);
            }
    }
};
struct EpiResid {
    static constexpr bool PERM = false, AFTER_DRAIN = false;
    const float* rlat; const float* rctx; float* out; const float* gate  ; float coef;
    __device__ __forceinline__ void operator()(const f32x4 (&acc)[2][2][4][2], const Unit& u, int wr, int wc, int fr, int fq) const {
        const bool lat = u.pm < 128; const int rix = lat ? (u.pm >> 4) : 8;
        const float* rb = lat ? rlat + (size_t)u.pm * BM * 1024 : rctx + (size_t)(u.pm - 128) * BM * 1024;
        float* ob = out + (size_t)u.pm * BM * 1024;
        const int col0 = u.pn * BM + wc * 32 + 4 * fq;
        f32x4 gv[2][2];
#pragma unroll
        for (int bj = 0; bj < 2; ++bj)
#pragma unroll
            for (int n = 0; n < 2; ++n) gv[bj][n] = *(const f32x4*)(gate + (size_t)rix * 9216 + col0 + bj * HALF + n * 16) * coef;
#pragma unroll
        for (int ai = 0; ai < 2; ++ai)
#pragma unroll
            for (int m = 0; m < 4; ++m) { const size_t off = (size_t)(ai * HALF + wr * 64 + m * 16 + fr) * 1024 + col0;
#pragma unroll
                for (int bj = 0; bj < 2; ++bj)
#pragma unroll
                    for (int n = 0; n < 2; ++n) { const f32x4 r = *(const f32x4*)(rb + off + bj * HALF + n * 16);
                        *(f32x4*)(ob + off + bj * HALF + n * 16) = r + gv[bj][n] * acc[ai][bj][m][n]; }
                if (m & 1) asm volatile("" ::: "memory"); }
    }
};
struct EpiResidS {
    static constexpr bool PERM = false, AFTER_DRAIN = false;
    const float* rlat; float* out; const float* gate; float* part;
    __device__ __forceinline__ void operator()(const f32x4 (&acc)[2][2][4][2], const Unit& u, int wr, int wc, int fr, int fq) const {
        const float* rlat_ = rlat; float* out_ = out; const float* gate_ = gate; float* part_ = part;
        const int col0 = u.pn * BM + wc * 32 + 4 * fq;
        if (u.pm >= 128) {
            float* pb = part_ + (size_t)(u.kt0 / 12) * (2048 * 1024) + (size_t)(u.pm - 128) * BM * 1024;
#pragma unroll
            for (int ai = 0; ai < 2; ++ai)
#pragma unroll
                for (int m = 0; m < 4; ++m) { const size_t off = (size_t)(ai * HALF + wr * 64 + m * 16 + fr) * 1024 + col0;
#pragma unroll
                    for (int bj = 0; bj < 2; ++bj)
#pragma unroll
                        for (int n = 0; n < 2; ++n) *(f32x4*)(pb + off + bj * HALF + n * 16) = acc[ai][bj][m][n]; }
            return;
        }
        const int rix = u.pm >> 4;
        const float* rb = rlat_ + (size_t)u.pm * BM * 1024; float* ob = out_ + (size_t)u.pm * BM * 1024;
        f32x4 gv[2][2];
#pragma unroll
        for (int bj = 0; bj < 2; ++bj)
#pragma unroll
            for (int n = 0; n < 2; ++n) gv[bj][n] = *(const f32x4*)(gate_ + (size_t)rix * 9216 + col0 + bj * HALF + n * 16) * 0.5f;
#pragma unroll
        for (int ai = 0; ai < 2; ++ai)
#pragma unroll
            for (int m = 0; m < 4; ++m) { const size_t off = (size_t)(ai * HALF + wr * 64 + m * 16 + fr) * 1024 + col0;
#pragma unroll
                for (int bj = 0; bj < 2; ++bj)
#pragma unroll
                    for (int n = 0; n < 2; ++n) { const f32x4 r = *(const f32x4*)(rb + off + bj * HALF + n * 16);
                        *(f32x4*)(ob + off + bj * HALF + n * 16) = r + gv[bj][n] * acc[ai][bj][m][n]; }
                if (m & 1) asm volatile("" ::: "memory"); }
    }
};
template <int COEF2, bool FINAL> struct EpiResidRms {
    static constexpr bool PERM = false, AFTER_DRAIN = false;
    const float* resid; float* xout; const float* gate; const float* g; const float* scm; const float* shm; bf16_t* hn; float* part; unsigned* cnt; PG8_LAS float* tab; float* splitpart  ;
    __device__ __forceinline__ void operator()(const f32x4 (&acc_c)[2][2][4][2], const Unit& u, int wr, int wc, int fr_in, int fq_in) const {
        f32x4 (&acc)[2][2][4][2] = const_cast<f32x4 (&)[2][2][4][2]>(acc_c);
        int fr = fr_in, fq = fq_in; asm volatile("" : "+v"(fr), "+v"(fq));
        if (splitpart != nullptr && u.pm >= 128) {
            float* sb = splitpart + (size_t)(u.kt0 / 12) * (2048 * 1024) + (size_t)(u.pm - 128) * BM * 1024; const int c0 = u.pn * BM + wc * 32 + 4 * fq;
#pragma unroll
            for (int ai = 0; ai < 2; ++ai)
#pragma unroll
                for (int m = 0; m < 4; ++m) { const size_t off = (size_t)(ai * HALF + wr * 64 + m * 16 + fr) * 1024 + c0;
#pragma unroll
                    for (int bj = 0; bj < 2; ++bj)
#pragma unroll
                        for (int n = 0; n < 2; ++n) *(f32x4*)(sb + off + bj * HALF + n * 16) = acc[ai][bj][m][n]; }
            return;
        }
        const float* resid_ = resid; float* xout_ = xout; const float* gate_ = gate; const float* g_ = g; const float* scm_ = scm; const float* shm_ = shm; bf16_t* hn_ = hn; float* part_ = part; unsigned* cnt_ = cnt; PG8_LAS float* tab_ = tab;
        const int rix = u.pm >> 4, col0 = u.pn * BM + wc * 32 + 4 * fq, wid = wr * 4 + wc, lane = fq * 16 + fr, tid = wid * 64 + lane;
        const float* rb = resid_ + (size_t)u.pm * BM * 1024; float* pb = part_ + (size_t)u.pm * BM * 16 + u.pn * 4 + wc;
        PG8_LAS float* vec = tab_ + 384; const int cl = wc * 32 + 4 * fq;
        if (tid < 256) { const int c = u.pn * BM + tid; vec[tid] = gate_[(size_t)rix * 9216 + c] * (0.5f * COEF2);
            if (FINAL) vec[256 + tid] = g_[c]; else { vec[256 + tid] = g_[c] * (scm_[(size_t)rix * 9216 + c] + 1.0f); vec[512 + tid] = shm_[(size_t)rix * 9216 + c]; } }
        asm volatile("s_waitcnt vmcnt(0) lgkmcnt(0)" ::: "memory"); __builtin_amdgcn_s_barrier(); asm volatile("" ::: "memory");
        {
#pragma unroll
          for (int ap = 0; ap < 4; ++ap) { const int ai = ap >> 1, m0 = (ap & 1) * 2; f32x4 rr[2][2][2];
              asm volatile("" ::: "memory");
#pragma unroll
              for (int mm = 0; mm < 2; ++mm) { const size_t off = (size_t)(ai * HALF + wr * 64 + (m0 + mm) * 16 + fr) * 1024 + col0;
#pragma unroll
                  for (int bj = 0; bj < 2; ++bj)
#pragma unroll
                      for (int n = 0; n < 2; ++n) rr[mm][bj][n] = __builtin_nontemporal_load((const f32x4*)(rb + off + bj * HALF + n * 16)); }
#pragma unroll
              for (int mm = 0; mm < 2; ++mm) { const int m = m0 + mm, rl = ai * HALF + wr * 64 + m * 16 + fr; float ss = 0.f;
#pragma unroll
                  for (int bj = 0; bj < 2; ++bj)
#pragma unroll
                      for (int n = 0; n < 2; ++n) { const f32x4 gv = *(const PG8_LAS f32x4*)(vec + cl + bj * HALF + n * 16); const f32x4 o = rr[mm][bj][n] + gv * acc[ai][bj][m][n];
                          acc[ai][bj][m][n] = o; ss += (o[0] * o[0] + o[1] * o[1]) + (o[2] * o[2] + o[3] * o[3]); }
                  ss += __shfl_xor(ss, 16); ss += __shfl_xor(ss, 32);
                  if (fq == 0) __hip_atomic_store(pb + (size_t)rl * 16, ss, __ATOMIC_RELAXED, __HIP_MEMORY_SCOPE_AGENT); } } }
        asm volatile("s_waitcnt vmcnt(0)" ::: "memory");
        unsigned* cw = cnt_ + 64 * u.pm;
        if (lane == 0) __hip_atomic_fetch_add(cw, 1u, __ATOMIC_RELAXED, __HIP_MEMORY_SCOPE_AGENT);
        if (wid == 0) { unsigned sp = 0;
            while ((unsigned)__builtin_amdgcn_readfirstlane(__hip_atomic_load(cw, __ATOMIC_RELAXED, __HIP_MEMORY_SCOPE_AGENT)) < 32u) { __builtin_amdgcn_s_sleep(2); if (++sp > (1u << 22)) break; } }
        asm volatile("s_waitcnt vmcnt(0) lgkmcnt(0)" ::: "memory"); __builtin_amdgcn_s_barrier(); asm volatile("" ::: "memory");
        if (tid < 256) { const unsigned long long* pp = (const unsigned long long*)(part_ + ((size_t)u.pm * BM + tid) * 16); float s = 0.f;
#pragma unroll
            for (int q = 0; q < 8; ++q) { const unsigned long long w = __hip_atomic_load(pp + q, __ATOMIC_RELAXED, __HIP_MEMORY_SCOPE_AGENT); s += __uint_as_float((unsigned)w) + __uint_as_float((unsigned)(w >> 32)); }
            tab_[tid] = 1.0f / sqrtf(s * (1.0f / 1024.0f) + 1e-6f); }
        asm volatile("s_waitcnt vmcnt(0) lgkmcnt(0)" ::: "memory"); __builtin_amdgcn_s_barrier(); asm volatile("" ::: "memory");
        { float* ob = xout_ + (size_t)u.pm * BM * 1024; bf16_t* hb = hn_ + (size_t)u.pm * BM * 1024;
#pragma unroll
          for (int ai = 0; ai < 2; ++ai)
#pragma unroll
            for (int m = 0; m < 4; ++m) { const int rl = ai * HALF + wr * 64 + m * 16 + fr; const size_t off = (size_t)rl * 1024 + col0; const float rs = tab_[rl];
#pragma unroll
                for (int bj = 0; bj < 2; ++bj)
#pragma unroll
                    for (int n = 0; n < 2; ++n) { const f32x4 gs = *(const PG8_LAS f32x4*)(vec + 256 + cl + bj * HALF + n * 16); const f32x4 o = acc[ai][bj][m][n];
                        if (FINAL) *(f32x4*)(ob + off + bj * HALF + n * 16) = o * rs * gs;
                        else { const f32x4 sh = *(const PG8_LAS f32x4*)(vec + 512 + cl + bj * HALF + n * 16);
                               __builtin_nontemporal_store(o, (f32x4*)(ob + off + bj * HALF + n * 16));     const f32x4 a = o * rs * gs + sh; u32x2 w; w.x = cvt_pk_bf16(a[0], a[1]); w.y = cvt_pk_bf16(a[2], a[3]); *(u32x2*)(hb + off + bj * HALF + n * 16) = w; } } }
        }
        asm volatile("s_waitcnt lgkmcnt(0)" ::: "memory"); __builtin_amdgcn_s_barrier(); asm volatile("" ::: "memory");
    }
};
struct EpiSplitRaw {
    static constexpr bool PERM = false, AFTER_DRAIN = false;
    float* part;
    __device__ __forceinline__ void operator()(const f32x4 (&acc)[2][2][4][2], const Unit& u, int wr, int wc, int fr, int fq) const {
        float* sb = part + (size_t)(u.kt0 / 12) * (2048 * 1024) + (size_t)(u.pm - 128) * BM * 1024; const int c0 = u.pn * BM + wc * 32 + 4 * fq;
#pragma unroll
        for (int ai = 0; ai < 2; ++ai)
#pragma unroll
            for (int m = 0; m < 4; ++m) { const size_t off = (size_t)(ai * HALF + wr * 64 + m * 16 + fr) * 1024 + c0;
#pragma unroll
                for (int bj = 0; bj < 2; ++bj)
#pragma unroll
                    for (int n = 0; n < 2; ++n) *(f32x4*)(sb + off + bj * HALF + n * 16) = acc[ai][bj][m][n]; }
    }
};
struct EpiInproj {
    static constexpr bool PERM = false, AFTER_DRAIN = false;
    bf16_t* HQ; bf16_t* KP; bf16_t* VP; float qs;
    __device__ __forceinline__ void operator()(const f32x4 (&acc)[2][2][4][2], const Unit& u, int wr, int wc, int fr, int fq) const {
        const int tt = u.pn >> 1; const bool lat = u.pm < 128; const bool rope = (tt < 2) && lat;
        const int row0 = u.pm * BM + wr * 64 + fr, cw = wc * 32 + 4 * fq;
        float fr4[4];
#pragma unroll
        for (int e = 0; e < 4; ++e) fr4[e] = __builtin_amdgcn_exp2f(-(float)(4 * fq + e) * (13.287712379549449f / 16.0f)) * 0.15915494309189535f;
        const float sc = (tt == 0) ? qs : 1.0f;
#pragma unroll
        for (int ai = 0; ai < 2; ++ai)
#pragma unroll
            for (int m = 0; m < 4; ++m) { const int row = row0 + ai * HALF + m * 16;
                bf16_t* p;
                if (tt == 0) p = HQ + (size_t)row * 512 + (u.pn & 1) * 256 + cw;
                else if (tt == 3) p = HQ + (size_t)34816 * 512 + ((size_t)((u.pn & 1) * 2) * 34816 + row) * 128 + cw;
                else { const int b = lat ? (row >> 12) : ((row - 32768) >> 8), kv = lat ? (row & 4095) : 4096 + ((row - 32768) & 255);
                       p = (tt == 1 ? KP : VP) + ((size_t)(b * 4 + (u.pn & 1) * 2) * 4352 + kv) * 128 + cw; }
                const size_t bjs = (tt == 0) ? (size_t)HALF : (tt == 3) ? (size_t)34816 * 128 : (size_t)4352 * 128;
                float cs[4], sn[4];
                if (rope) { const int t = row & 4095; const float pos = (float)((wc & 1) ? (t & 63) : (t >> 6));
#pragma unroll
                    for (int e = 0; e < 4; ++e) { const float rev = __builtin_amdgcn_fractf(pos * fr4[e]); cs[e] = __builtin_amdgcn_cosf(rev) * sc; sn[e] = __builtin_amdgcn_sinf(rev) * sc; } }
                else {
#pragma unroll
                    for (int e = 0; e < 4; ++e) { cs[e] = sc; sn[e] = 0.f; } }
#pragma unroll
                for (int bj = 0; bj < 2; ++bj) { const f32x4 a0 = acc[ai][bj][m][0], a1 = acc[ai][bj][m][1]; float o0[4], o1[4];
#pragma unroll
                    for (int e = 0; e < 4; ++e) { o0[e] = a0[e] * cs[e] - a1[e] * sn[e]; o1[e] = a1[e] * cs[e] + a0[e] * sn[e]; }
                    u32x2 w0, w1; w0.x = cvt_pk_bf16(o0[0], o0[1]); w0.y = cvt_pk_bf16(o0[2], o0[3]); w1.x = cvt_pk_bf16(o1[0], o1[1]); w1.y = cvt_pk_bf16(o1[2], o1[3]);
                    *(u32x2*)(p + bj * bjs) = w0; *(u32x2*)(p + bj * bjs + 16) = w1; }
            }
    }
};
template <class Epi, class Sched, bool ALIGN_EPI = false, bool SP2 = false>
__device__ __forceinline__ void gemm_phase(PG8_LAS unsigned char* lds, const Gemm g, const Sched& S, const Epi& E) {
    int tid_l = threadIdx.x; asm volatile("" : "+v"(tid_l));
    const int tid = tid_l, wid = __builtin_amdgcn_readfirstlane(tid >> 6), lane = tid & 63, wr = wid >> 2, wc = wid & 3, fr = lane & 15, fq = lane >> 4;
    const int K = g.K; int nt = 0;
    unsigned voffA[2], voffB[2];
#pragma unroll
    for (int i = 0; i < 2; ++i) { int R, C; stage_rc(tid * 16 + i * 8192, R, C); const int Rb = Epi::PERM ? ((R & ~31) + perm32(R & 31)) : R;
        voffA[i] = (unsigned)(R * K + C) * 2u; voffB[i] = (unsigned)(Rb * K + C) * 2u; }
    const size_t kstep = (size_t)(BK * 2);
    const size_t hstep = (size_t)HALF * K * 2;
    const size_t tstep = 2 * hstep;
    const unsigned ldsw = (unsigned)wid * 1024u;
    const int aoff = lds_byte(wr * 64 + fr, fq * 8), boff = lds_byte(wc * 32 + fr, fq * 8);
#define PG8_SA(b, h) (((b) * 2 + (h)) * HTB)
#define PG8_SB(b, h) ((4 + (b) * 2 + (h)) * HTB)
#define PG8_STAGE(bufoff, gbase, voff) do { _Pragma("unroll") for (int _i = 0; _i < 2; ++_i) \
        __builtin_amdgcn_global_load_lds((const unsigned*)((const char*)(gbase) + (voff)[_i]), (PG8_LAS unsigned*)(lds + (bufoff) + ldsw + _i * 8192), 16, 0, 0); } while (0)
#define PG8_LDA(dst, b, h) do { _Pragma("unroll") for (int m = 0; m < 4; ++m) _Pragma("unroll") for (int k = 0; k < 2; ++k) dst[m][k] = *(const PG8_LAS bf16x8*)(lds + PG8_SA(b, h) + aoff + m * 2048 + k * 1024); } while (0)
#define PG8_LDB(dst, b, h) do { _Pragma("unroll") for (int n = 0; n < 2; ++n) _Pragma("unroll") for (int k = 0; k < 2; ++k) dst[n][k] = *(const PG8_LAS bf16x8*)(lds + PG8_SB(b, h) + boff + n * 2048 + k * 1024); } while (0)
#define PG8_MMA(ai, bj, At, Bt) do { __builtin_amdgcn_s_setprio(1); _Pragma("unroll") for (int m = 0; m < 4; ++m) _Pragma("unroll") for (int n = 0; n < 2; ++n) _Pragma("unroll") for (int k = 0; k < 2; ++k) \
        acc[ai][bj][m][n] = __builtin_amdgcn_mfma_f32_16x16x32_bf16(Bt[n][k], At[m][k], acc[ai][bj][m][n], 0, 0, 0); __builtin_amdgcn_s_setprio(0); } while (0)
#define PG8_WAIT_V(n) asm volatile("s_waitcnt vmcnt(" #n ")" ::: "memory")
#define PG8_WAIT_L(n) asm volatile("s_waitcnt lgkmcnt(" #n ")" ::: "memory")
#define PG8_BAR __builtin_amdgcn_s_barrier()
#define PG8_SCHED __builtin_amdgcn_sched_barrier(0)
    Unit cur, nxt; int ui = 0;
    if (!S.next(0, cur)) return;
    f32x4 acc[2][2][4][2];
#pragma unroll
    for (int a = 0; a < 2; ++a)
#pragma unroll
        for (int b = 0; b < 2; ++b)
#pragma unroll
            for (int m = 0; m < 4; ++m)
#pragma unroll
                for (int n = 0; n < 2; ++n) acc[a][b][m][n] = (f32x4){0.f, 0.f, 0.f, 0.f};
    bf16x8 At[4][2], B0[2][2], B1[2][2];
    nt = cur.nk;
    const char* cA = (const char*)g.A + (size_t)cur.pm * tstep + (size_t)cur.kt0 * kstep; const char* cB = (const char*)g.Bt + (size_t)cur.pn * tstep + (size_t)cur.kt0 * kstep;
    S.a_ready(cur);
    if constexpr (SP2) {
        PG8_STAGE(PG8_SB(0, 0), cB, voffB); PG8_STAGE(PG8_SB(0, 1), cB + hstep, voffB); PG8_STAGE(PG8_SA(0, 0), cA, voffA); PG8_STAGE(PG8_SA(0, 1), cA + hstep, voffA);
        if (wr == 1) PG8_BAR;
        PG8_WAIT_V(2); PG8_BAR;
        PG8_STAGE(PG8_SB(1, 0), cB + kstep, voffB); PG8_STAGE(PG8_SA(1, 0), cA + kstep, voffA); PG8_STAGE(PG8_SB(1, 1), cB + hstep + kstep, voffB);
        PG8_WAIT_V(6); PG8_BAR;
    } else {
        PG8_STAGE(PG8_SB(0, 0), cB, voffB); PG8_STAGE(PG8_SA(0, 0), cA, voffA); PG8_STAGE(PG8_SB(0, 1), cB + hstep, voffB); PG8_STAGE(PG8_SA(0, 1), cA + hstep, voffA);
        if (wr == 1) PG8_BAR;
        PG8_WAIT_V(4); PG8_BAR;
        PG8_STAGE(PG8_SB(1, 0), cB + kstep, voffB); PG8_STAGE(PG8_SA(1, 0), cA + kstep, voffA); PG8_STAGE(PG8_SB(1, 1), cB + hstep + kstep, voffB);
        PG8_WAIT_V(6); PG8_BAR;
    }
    for (;;) {
        const bool has_next = S.next(ui + 1, nxt);
        const char* nA = has_next ? (const char*)g.A + (size_t)nxt.pm * tstep + (size_t)nxt.kt0 * kstep : cA; const char* nB = has_next ? (const char*)g.Bt + (size_t)nxt.pn * tstep + (size_t)nxt.kt0 * kstep : cB;
        for (int t = 0; t < nt; t += 2) {
            const bool last = (t == nt - 2);
            const char* a1 = cA + (size_t)(t + 1) * kstep;
            const char* a2 = last ? nA : cA + (size_t)(t + 2) * kstep; const char* b2 = last ? nB : cB + (size_t)(t + 2) * kstep;
            const char* a3 = a2 + kstep; const char* b3 = b2 + kstep;
            if (last && has_next) S.a_ready(nxt);
            if constexpr (SP2) {
            PG8_LDB(B0, 0, 0); PG8_LDB(B1, 0, 1); PG8_SCHED; PG8_LDA(At, 0, 0); PG8_STAGE(PG8_SA(1, 1), a1 + hstep, voffA);
            PG8_WAIT_V(8); PG8_WAIT_L(0); PG8_BAR; PG8_MMA(0, 0, At, B0); PG8_MMA(0, 1, At, B1); PG8_BAR; PG8_SCHED;
            PG8_LDA(At, 0, 1); PG8_STAGE(PG8_SB(0, 0), b2, voffB); PG8_STAGE(PG8_SB(0, 1), b2 + hstep, voffB); PG8_STAGE(PG8_SA(0, 0), a2, voffA);
            PG8_WAIT_V(8); PG8_WAIT_L(0); PG8_BAR; PG8_MMA(1, 0, At, B0); PG8_MMA(1, 1, At, B1); PG8_BAR; PG8_SCHED;
            PG8_LDB(B0, 1, 0); PG8_LDB(B1, 1, 1); PG8_SCHED; PG8_LDA(At, 1, 0); PG8_STAGE(PG8_SA(0, 1), a2 + hstep, voffA);
            PG8_WAIT_V(8); PG8_WAIT_L(0); PG8_BAR; PG8_MMA(0, 0, At, B0); PG8_MMA(0, 1, At, B1); PG8_BAR; PG8_SCHED;
            PG8_LDA(At, 1, 1); PG8_STAGE(PG8_SB(1, 0), b3, voffB); PG8_STAGE(PG8_SB(1, 1), b3 + hstep, voffB); PG8_STAGE(PG8_SA(1, 0), a3, voffA);
            PG8_WAIT_V(8); PG8_WAIT_L(0); PG8_BAR; PG8_MMA(1, 0, At, B0); PG8_MMA(1, 1, At, B1); PG8_BAR; PG8_SCHED;
            } else {
            PG8_LDB(B0, 0, 0); PG8_SCHED; PG8_LDA(At, 0, 0); PG8_STAGE(PG8_SA(1, 1), a1 + hstep, voffA);
            PG8_WAIT_L(8); PG8_BAR; PG8_WAIT_L(0); PG8_MMA(0, 0, At, B0); PG8_BAR; PG8_SCHED;
            PG8_LDB(B1, 0, 1); PG8_STAGE(PG8_SB(0, 0), b2, voffB);
            PG8_BAR; PG8_WAIT_L(0); PG8_MMA(0, 1, At, B1); PG8_BAR;
            PG8_LDA(At, 0, 1); PG8_STAGE(PG8_SA(0, 0), a2, voffA);
            PG8_BAR; PG8_WAIT_L(0); PG8_MMA(1, 0, At, B0); PG8_BAR; PG8_SCHED;
            PG8_STAGE(PG8_SB(0, 1), b2 + hstep, voffB);
            PG8_WAIT_V(6); PG8_BAR; PG8_MMA(1, 1, At, B1); PG8_BAR;
            PG8_LDB(B0, 1, 0); PG8_SCHED; PG8_LDA(At, 1, 0); PG8_STAGE(PG8_SA(0, 1), a2 + hstep, voffA);
            PG8_WAIT_L(8); PG8_BAR; PG8_WAIT_L(0); PG8_MMA(0, 0, At, B0); PG8_BAR; PG8_SCHED;
            PG8_LDB(B1, 1, 1); PG8_STAGE(PG8_SB(1, 0), b3, voffB);
            PG8_BAR; PG8_WAIT_L(0); PG8_MMA(0, 1, At, B1); PG8_BAR;
            PG8_LDA(At, 1, 1); PG8_STAGE(PG8_SA(1, 0), a3, voffA);
            PG8_BAR; PG8_WAIT_L(0); PG8_MMA(1, 0, At, B0); PG8_BAR; PG8_SCHED;
            PG8_STAGE(PG8_SB(1, 1), b3 + hstep, voffB);
            PG8_WAIT_V(6); PG8_BAR; PG8_MMA(1, 1, At, B1); PG8_BAR;
            }
        }
        if constexpr (ALIGN_EPI) { if (wr == 0) PG8_BAR; }
        if constexpr (!Epi::AFTER_DRAIN) { E(acc, cur, wr, wc, fr, fq); S.done(cur); }
        if (!has_next) break;
#pragma unroll
        for (int a = 0; a < 2; ++a)
#pragma unroll
            for (int b = 0; b < 2; ++b)
#pragma unroll
                for (int m = 0; m < 4; ++m)
#pragma unroll
                    for (int n = 0; n < 2; ++n) acc[a][b][m][n] = (f32x4){0.f, 0.f, 0.f, 0.f};
        cur = nxt; cA = nA; cB = nB; ++ui; nt = cur.nk;
        if constexpr (ALIGN_EPI) { if (wr == 1) PG8_BAR; }
    }
    PG8_WAIT_V(0);
    if constexpr (!ALIGN_EPI) { if (wr == 0) PG8_BAR; }
    PG8_BAR;
    if constexpr (Epi::AFTER_DRAIN) { E.fused(acc, cur, wr, wc, fr, fq, lds, wid, lane); S.done(cur); }
#undef PG8_SA
#undef PG8_SB
#undef PG8_STAGE
#undef PG8_LDA
#undef PG8_LDB
#undef PG8_MMA
#undef PG8_WAIT_V
#undef PG8_WAIT_L
#undef PG8_BAR
#undef PG8_SCHED
}
}

#include <hip/hip_cooperative_groups.h>
namespace cg = cooperative_groups;
#define LAS __attribute__((address_space(3)))
typedef unsigned short bf16;
typedef unsigned u32x4 __attribute__((ext_vector_type(4)));
typedef unsigned u32x2 __attribute__((ext_vector_type(2)));
typedef float f32x4 __attribute__((ext_vector_type(4)));
typedef float f32x16 __attribute__((ext_vector_type(16)));
typedef short bf16x8 __attribute__((ext_vector_type(8)));
typedef short s16x4 __attribute__((ext_vector_type(4)));

constexpr int D = 1024, NB = 8, SEQ = 4096, CTX = 256, DFF = 2816, NLAT = NB * SEQ  , NTOK = NLAT + NB * CTX  , INW = 2048, NMOD = 9 * D;
constexpr float EPS = 1e-6f, QSCALE = 0.125f * 1.4426950408889634f, LAM_INIT = 0.2f;
constexpr size_t MiB = 1u << 20;
constexpr size_t WS_BAR = 512 * 1024, WS_MOD = 0, WS_W1A = 1 * MiB, WS_W2A = 12 * MiB, WS_W1B = 18 * MiB, WS_W2B = 29 * MiB, WS_WIN = 35 * MiB, WS_WOUT = 39 * MiB, WS_WP = 41 * MiB,
                 WS_HN = 48 * MiB, WS_X1 = 116 * MiB, WS_BIG = 252 * MiB, WS_END = 440 * MiB;
static_assert(WS_HN + (size_t)NTOK * D * 2 <= WS_X1 && WS_X1 + (size_t)NTOK * D * 4 <= WS_BIG && WS_BIG + (size_t)NTOK * DFF * 2 <= WS_END, "ws map");
constexpr int LDS_BYTES = 147456, NWAVES = 8, NPHASE = 12;
#ifndef MK_N_LAUNCHES
#define MK_N_LAUNCHES 1
#endif

__device__ __forceinline__ unsigned f2bf(float f) { unsigned u = __builtin_bit_cast(unsigned, f); return (u + 0x7fffu + ((u >> 16) & 1u)) >> 16; }
__device__ __forceinline__ unsigned pk2(float lo, float hi) { return f2bf(lo) | (f2bf(hi) << 16); }
__device__ __forceinline__ unsigned cvtpk(float lo, float hi) { unsigned r; asm volatile("v_cvt_pk_bf16_f32 %0, %1, %2" : "=v"(r) : "v"(lo), "v"(hi)); return r; }
__device__ __forceinline__ float bflo(unsigned w) { return __builtin_bit_cast(float, w << 16); }
__device__ __forceinline__ float bfhi(unsigned w) { return __builtin_bit_cast(float, w & 0xffff0000u); }
__device__ __forceinline__ float wave_sum(float v) {
#pragma unroll
    for (int o = 1; o < 64; o <<= 1) v += __shfl_xor(v, o);
    return v;
}
__device__ __forceinline__ int crow(int r, int hi) { return (r & 3) + 8 * (r >> 2) + 4 * hi; }

__device__ __forceinline__ void adaln_unit(LAS unsigned char* lds, int unit, const float* c, const float* c_ctx, const float* w_mod, const float* b_mod, float* mod, int tid) {
    LAS float* scond = (LAS float*)lds;
    LAS float* part = (LAS float*)(lds + 36864);
    for (int i = tid; i < 9 * D; i += 512) { const int r = i >> 10, k = i & 1023; const float v = (r < 8) ? c[r * D + k] : c_ctx[k]; scond[i] = v / (1.0f + __expf(-v)); }
    __syncthreads();
    const int cgp = tid & 15, ks = tid >> 4;
    f32x4 acc[9];
#pragma unroll
    for (int r = 0; r < 9; ++r) acc[r] = (f32x4){0.f, 0.f, 0.f, 0.f};
    const float* wp = w_mod + (size_t)(32 * ks) * NMOD + 64 * unit + 4 * cgp;
#pragma unroll 8
    for (int kk = 0; kk < 32; ++kk) { const f32x4 w = *(const f32x4*)(wp + (size_t)kk * NMOD);
#pragma unroll
        for (int r = 0; r < 9; ++r) acc[r] += w * scond[r * D + 32 * ks + kk]; }
#pragma unroll
    for (int r = 0; r < 9; ++r) *(LAS f32x4*)(part + (ks * 9 + r) * 64 + 4 * cgp) = acc[r];
    __syncthreads();
    for (int o = tid; o < 9 * 64; o += 512) { const int r = o >> 6, cc = o & 63; float s = 0.f;
#pragma unroll 8
        for (int k2 = 0; k2 < 32; ++k2) s += part[(k2 * 9 + r) * 64 + cc];
        mod[(size_t)r * NMOD + 64 * unit + cc] = s + b_mod[64 * unit + cc]; }
    __syncthreads();
}
__device__ __forceinline__ void transpose_item(const float* W, int ldw, bf16* WT, int ldt, int k0, int n0, int drow0, LAS float* scr, int lane) {
#pragma unroll 8
    for (int i = 0; i < 32; ++i) { const int kk = 2 * i + (lane >> 5); scr[kk * 33 + (lane & 31)] = __builtin_nontemporal_load(W + (size_t)(k0 + kk) * ldw + n0 + (lane & 31)); }
    asm volatile("s_waitcnt lgkmcnt(0)" ::: "memory");
    const int c = lane & 7;
#pragma unroll
    for (int j = 0; j < 4; ++j) { const int n = (lane >> 3) + 8 * j; const LAS float* s = scr + (8 * c) * 33 + n;
        u32x4 o; o.x = pk2(s[0 * 33], s[1 * 33]); o.y = pk2(s[2 * 33], s[3 * 33]); o.z = pk2(s[4 * 33], s[5 * 33]); o.w = pk2(s[6 * 33], s[7 * 33]);
        *(u32x4*)(WT + (size_t)(drow0 + n) * ldt + k0 + 8 * c) = o; }
    asm volatile("s_waitcnt lgkmcnt(0)" ::: "memory");
}
__device__ __forceinline__ void transpose_mat_item(const float* W, int K, int N, bf16* WT, bool swiglu, int item, LAS float* scr, int lane) {
    const int nblk = N / 32, kb = item / nblk, nb = item % nblk, n0 = 32 * nb; int drow0 = n0;
    if (swiglu) { const int half = N / 2; const int j = (n0 < half) ? n0 : n0 - half; drow0 = (j >> 7) * 256 + ((n0 < half) ? 0 : 128) + (j & 127); }
    transpose_item(W, N, WT, K, 64 * kb, n0, drow0, scr, lane);
}

__device__ __forceinline__ void norm_pass(const float* lat, const float* ctxp, int nrows, const float* g, const float* mod, int sh_i, int sc_i, bf16* dst, float* dstf, int wave, int lane, const float* part = nullptr, const float* pgate = nullptr, int row_begin = 0) {
    const int gw = blockIdx.x * NWAVES + wave, NGW = gridDim.x * NWAVES, nch = nrows >> 2;
    for (int ch = gw + (row_begin >> 2); ch < nch; ch += NGW) {
        const int row0 = ch * 4; const bool isl = row0 < NLAT; const int rix = isl ? (row0 >> 12) : 8;
        const float* src = isl ? lat + (size_t)row0 * D : ctxp + (size_t)(row0 - NLAT) * D;
        f32x4 gs[4], sh[4];
#pragma unroll
        for (int j = 0; j < 4; ++j) { const int col = 4 * lane + 256 * j; gs[j] = *(const f32x4*)(g + col);
            if (mod) { gs[j] = gs[j] * (*(const f32x4*)(mod + (size_t)rix * NMOD + sc_i * D + col) + 1.0f); sh[j] = *(const f32x4*)(mod + (size_t)rix * NMOD + sh_i * D + col); }
            else sh[j] = (f32x4){0.f, 0.f, 0.f, 0.f}; }
#pragma unroll
        for (int rr = 0; rr < 4; ++rr) {
            f32x4 v[4]; float ss = 0.f;
#pragma unroll
            for (int j = 0; j < 4; ++j) { v[j] = __builtin_nontemporal_load((const f32x4*)(src + (size_t)rr * D + 4 * lane + 256 * j));
                if (part && !isl) { const float* pp = part + (size_t)(row0 - NLAT + rr) * D + 4 * lane + 256 * j; const size_t ps = (size_t)2048 * 1024;
                    const f32x4 sp = (*(const f32x4*)pp + *(const f32x4*)(pp + ps)) + (*(const f32x4*)(pp + 2 * ps) + *(const f32x4*)(pp + 3 * ps));
                    v[j] = v[j] + sp * (*(const f32x4*)(pgate + 4 * lane + 256 * j) * 0.5f); }
                ss += (v[j].x * v[j].x + v[j].y * v[j].y) + (v[j].z * v[j].z + v[j].w * v[j].w); }
            const float rstd = 1.0f / sqrtf(wave_sum(ss) * (1.0f / D) + EPS);
#pragma unroll
            for (int j = 0; j < 4; ++j) { const f32x4 o = v[j] * rstd * gs[j] + sh[j]; const size_t off = (size_t)(row0 + rr) * D + 4 * lane + 256 * j;
                if (dstf) __builtin_nontemporal_store(o, (f32x4*)(dstf + off));
                else { u32x2 w; w.x = pk2(o.x, o.y); w.y = pk2(o.z, o.w); *(u32x2*)(dst + off) = w; } }
        }
    }
}

constexpr int PU_STRIDE = 320, PU_ROWS = 144, PO_OFF = PU_ROWS * PU_STRIDE  , PW_OFF = PO_OFF + 128 * 272  ;
__device__ __forceinline__ bf16x8 pfrag(const LAS unsigned char* p) { const s16x4 vl = __builtin_bit_cast(s16x4, __builtin_amdgcn_ds_read_tr16_b64_v4i16((LAS s16x4*)p)), vh = __builtin_bit_cast(s16x4, __builtin_amdgcn_ds_read_tr16_b64_v4i16((LAS s16x4*)(p + 8 * PU_STRIDE)));
    return (bf16x8){vl[0], vl[1], vl[2], vl[3], vh[0], vh[1], vh[2], vh[3]}; }
__device__ __forceinline__ void pool_load(int rb, int gi, const bf16* HX, const bf16* WPt, u32x4 (&v)[5], u32x4 (&wv)[4], int tid) {
    const int b = rb >> 5, t0 = (rb & 31) * 128;
#pragma unroll
    for (int k = 0; k < 5; ++k) { const int cidx = tid + 512 * k, i = cidx >> 4, ch = cidx & 15, t = t0 - 8 + i; v[k] = (u32x4){0u, 0u, 0u, 0u};
        if (cidx < PU_ROWS * 16 && t >= 0 && t < SEQ) v[k] = __builtin_nontemporal_load((const u32x4*)(HX + (size_t)NTOK * 512 + ((size_t)gi * NTOK + (size_t)b * SEQ + t) * 128 + ch * 8)); }
#pragma unroll
    for (int k = 0; k < 4; ++k) { const int cidx = tid + 512 * k; wv[k] = *(const u32x4*)(WPt + (size_t)gi * 128 * 128 + cidx * 8); }
}
__device__ __forceinline__ void pool_stage(LAS unsigned char* lds, const u32x4 (&v)[5], const u32x4 (&wv)[4], int tid) {
#pragma unroll
    for (int k = 0; k < 5; ++k) { const int cidx = tid + 512 * k, i = cidx >> 4, ch = cidx & 15; if (cidx < PU_ROWS * 16) *(LAS u32x4*)(lds + i * PU_STRIDE + ch * 16) = v[k]; }
#pragma unroll
    for (int k = 0; k < 4; ++k) { const int cidx = tid + 512 * k, n = cidx >> 4, ch = cidx & 15; *(LAS u32x4*)(lds + PW_OFF + n * 272 + ch * 16) = wv[k]; }
}
__device__ __forceinline__ void pool_compute(LAS unsigned char* lds, int rb, int gi, const float* pool_scale, bf16* MIX, int tid, int wave, int lane) {
    const int b = rb >> 5, t0 = (rb & 31) * 128, lo = 1 << gi;
    const int r32 = lane & 31, hi = lane >> 5, tb = wave & 3, half = wave >> 2;
    f32x16 acc[4]; acc[0] = f32x16{}; acc[1] = f32x16{}; acc[2] = f32x16{}; acc[3] = f32x16{};
    { const LAS unsigned char* ub = lds + (4 * hi + ((lane & 15) >> 2)) * PU_STRIDE + (16 * ((lane >> 4) & 1) + 4 * (lane & 3)) * 2;
#pragma unroll
      for (int ksl = 0; ksl < 3; ++ksl) { const int ks = 2 * tb + ksl;
          u32x4 bw;
#pragma unroll
          for (int jj = 0; jj < 4; ++jj) { const int j0 = 2 * jj, j1 = 2 * jj + 1;
              const int d0 = 16 * ks + 4 * hi + (j0 & 3) + 8 * (j0 >> 2) - 8 - (32 * tb + r32), d1 = 16 * ks + 4 * hi + (j1 & 3) + 8 * (j1 >> 2) - 8 - (32 * tb + r32);
              bw[jj] = ((d0 >= -lo && d0 < lo) ? 0x3F80u : 0u) | ((d1 >= -lo && d1 < lo) ? 0x3F800000u : 0u); }
          const bf16x8 bfr = __builtin_bit_cast(bf16x8, bw);
#pragma unroll
          for (int cb = 0; cb < 4; ++cb) acc[cb] = __builtin_amdgcn_mfma_f32_32x32x16_bf16(pfrag(ub + ks * 16 * PU_STRIDE + cb * 64), bfr, acc[cb], 0, 0, 0); } }
    bf16x8 dfr[8];
    { const int t = t0 + 32 * tb + r32; const int st = (t - lo > 0) ? t - lo : 0, en = (t + lo - 1 < SEQ - 1) ? t + lo - 1 : SEQ - 1; const float inv = 1.0f / (float)(en - st + 1);
      const LAS unsigned char* own = lds + (32 * tb + r32 + 8) * PU_STRIDE + 8 * hi;
#pragma unroll
      for (int cb = 0; cb < 4; ++cb) { u32x2 dw[4];
#pragma unroll
          for (int g4 = 0; g4 < 4; ++g4) { const u32x2 o2 = *(const LAS u32x2*)(own + (32 * cb + 8 * g4) * 2);
              dw[g4].x = cvtpk(acc[cb][4 * g4] * inv - bflo(o2.x), acc[cb][4 * g4 + 1] * inv - bfhi(o2.x)); dw[g4].y = cvtpk(acc[cb][4 * g4 + 2] * inv - bflo(o2.y), acc[cb][4 * g4 + 3] * inv - bfhi(o2.y)); }
          dfr[2 * cb] = __builtin_bit_cast(bf16x8, (u32x4){dw[0].x, dw[0].y, dw[1].x, dw[1].y}); dfr[2 * cb + 1] = __builtin_bit_cast(bf16x8, (u32x4){dw[2].x, dw[2].y, dw[3].x, dw[3].y}); } }
    f32x16 out[2]; out[0] = f32x16{}; out[1] = f32x16{};
#pragma unroll
    for (int nbl = 0; nbl < 2; ++nbl) { const LAS unsigned char* wrow = lds + PW_OFF + (32 * (2 * half + nbl) + r32) * 272 + 8 * hi;
#pragma unroll
        for (int kq = 0; kq < 8; ++kq) { const u32x2 a0 = *(const LAS u32x2*)(wrow + 32 * kq), a1 = *(const LAS u32x2*)(wrow + 32 * kq + 16);
            out[nbl] = __builtin_amdgcn_mfma_f32_32x32x16_bf16(__builtin_bit_cast(bf16x8, (u32x4){a0.x, a0.y, a1.x, a1.y}), dfr[kq], out[nbl], 0, 0, 0); } }
    { LAS unsigned char* ot = lds + PO_OFF + (32 * tb + r32) * 272;
#pragma unroll
      for (int nbl = 0; nbl < 2; ++nbl)
#pragma unroll
        for (int rq = 0; rq < 4; ++rq) { const int n0 = 32 * (2 * half + nbl) + 8 * rq + 4 * hi; const f32x4 ps = *(const f32x4*)(pool_scale + gi * 128 + n0);
            u32x2 w; w.x = cvtpk(out[nbl][4 * rq] * ps.x, out[nbl][4 * rq + 1] * ps.y); w.y = cvtpk(out[nbl][4 * rq + 2] * ps.z, out[nbl][4 * rq + 3] * ps.w);
            *(LAS u32x2*)(ot + n0 * 2) = w; } }
    __syncthreads();
#pragma unroll
    for (int k = 0; k < 4; ++k) { const int cidx = tid + 512 * k, row = cidx >> 4, ch = cidx & 15;
        *(u32x4*)(MIX + ((size_t)b * SEQ + t0 + row) * D + 512 + gi * 128 + ch * 8) = *(const LAS u32x4*)(lds + PO_OFF + row * 272 + ch * 16); }
}

constexpr int AK_STRIDE = 144, AV_STRIDE = 320, AK_BYTES = 64 * AK_STRIDE, AKS = 2 * AK_BYTES  , AVS = 64 * AV_STRIDE  , AV_BASE = 3 * AKS;
#define SBAR() __builtin_amdgcn_sched_barrier(0)
typedef float f32x2_t __attribute__((ext_vector_type(2))); typedef __bf16 bf16x2_t __attribute__((ext_vector_type(2)));
__device__ __forceinline__ unsigned cvtpk_s(float lo, float hi) { f32x2_t v = {lo, hi}; bf16x2_t bb = __builtin_convertvector(v, bf16x2_t); return __builtin_bit_cast(unsigned, bb); }
__device__ __forceinline__ s16x4 vtr(const LAS unsigned char* p) { return __builtin_bit_cast(s16x4, __builtin_amdgcn_ds_read_tr16_b64_v4i16((LAS s16x4*)p)); }
__device__ __forceinline__ bf16x8 vfrag(const LAS unsigned char* p) { const s16x4 vl = vtr(p), vh = vtr(p + 8 * AV_STRIDE); return (bf16x8){vl[0], vl[1], vl[2], vl[3], vh[0], vh[1], vh[2], vh[3]}; }
__device__ __forceinline__ void glds16(const void* gsrc, unsigned lds_dst) { unsigned keep;
    asm volatile("s_mov_b32 %0, m0\n\ts_mov_b32 m0, %2\n\ts_nop 0\n\tglobal_load_lds_dwordx4 %1, off\n\ts_mov_b32 m0, %0" : "=&s"(keep) : "v"(gsrc), "s"(lds_dst) : "memory"); }
__device__ __forceinline__ float max3f(float a, float b, float c) { float r; asm("v_max3_f32 %0, %1, %2, %3" : "=v"(r) : "v"(a), "v"(b), "v"(c)); return r; }
#define WAIT_BAR0() asm volatile("s_waitcnt vmcnt(0) lgkmcnt(0)\n\ts_barrier" ::: "memory")
#define WAIT_BAR5() asm volatile("s_waitcnt vmcnt(5) lgkmcnt(0)\n\ts_barrier" ::: "memory")
template <int MODE> __device__ __forceinline__ void attn_unit(LAS unsigned char* lds, int b, int h, int qb, const bf16* HQ, const bf16* KP, const bf16* VP, bf16* MIX, const float* g_sub, float lam, int tid, int wave, int lane) {
    const int r32 = lane & 31, hi = lane >> 5, map = wave >> 2, qw = wave & 3;
    const size_t qrow = (size_t)b * SEQ + qb * 128 + qw * 32 + r32;
    bf16x8 qf[4];
#pragma unroll
    for (int d0 = 0; d0 < 4; ++d0) qf[d0] = *(const bf16x8*)(HQ + qrow * 512 + h * 128 + map * 64 + d0 * 16 + hi * 8);
    unsigned soff[5], ldst[5]; bool isv[5], valid[5];
#pragma unroll
    for (int i = 0; i < 5; ++i) { const int bid = wave + 8 * i; valid[i] = bid < 38; isv[i] = bid >= 18;
        if (bid < 18) { const int km = bid / 9, j = bid % 9, p = 64 * j + lane, row = p / 9; int ch = p % 9; if (ch == 8) ch = 0;
            soff[i] = (unsigned)(row * 128 + km * 64 + ch * 8) * 2u; ldst[i] = km * AK_BYTES + j * 1024; }
        else { const int j = bid - 18, p = 64 * j + lane, row = p / 20; int ch = p % 20; if (ch >= 16) ch = 0;
            soff[i] = (unsigned)(row * 128 + ch * 8) * 2u; ldst[i] = j * 1024; } }
    if (!valid[4]) { soff[4] = soff[0]; ldst[4] = ldst[0]; isv[4] = isv[0]; valid[4] = true; }
    const unsigned lds0 = (unsigned)(uintptr_t)lds;
    const char* kbase = (const char*)(KP + (size_t)(b * 4 + h) * 4352 * 128); const char* vbase = (const char*)(VP + (size_t)(b * 4 + h) * 4352 * 128);
#define DMA_I(i, tk, sk, tv, sv, dok, dov) do { if (!(MODE & 2) && (isv[i] ? (dov) : (dok))) { const int tt_ = isv[i] ? (tv) : (tk); \
        glds16((isv[i] ? vbase : kbase) + (size_t)tt_ * 16384 + soff[i], (unsigned)__builtin_amdgcn_readfirstlane(lds0 + (isv[i] ? AV_BASE + (sv) * AVS : (sk) * AKS) + ldst[i])); } } while (0)
#define DMA_KV(tk, sk, tv, sv, dok, dov) do { DMA_I(0, tk, sk, tv, sv, dok, dov); DMA_I(1, tk, sk, tv, sv, dok, dov); DMA_I(2, tk, sk, tv, sv, dok, dov); DMA_I(3, tk, sk, tv, sv, dok, dov); DMA_I(4, tk, sk, tv, sv, dok, dov); } while (0)
    constexpr int NT = (SEQ + CTX) / 64;
    DMA_KV(0, 0, 0, 0, true, false);
    DMA_KV(1, 1, 0, 0, true, true);
    WAIT_BAR5();
    f32x16 o[4]; o[0] = f32x16{}; o[1] = f32x16{}; o[2] = f32x16{}; o[3] = f32x16{};
    const f32x16 zero16 = f32x16{};
    float mrun = -INFINITY, lrun = 0.f;
    const unsigned koff = map * AK_BYTES + r32 * AK_STRIDE + hi * 16;
    const unsigned voff = AV_BASE + (4 * hi + ((lane & 15) >> 2)) * AV_STRIDE + (16 * ((lane >> 4) & 1) + 4 * (lane & 3)) * 2;
    u32x4 pw[4];
    f32x16 X0, X1;
#define KFR(i) (*(const LAS bf16x8*)(kb_ + (1 - ((i) >> 2)) * 32 * AK_STRIDE + ((i) & 3) * 32))
#define VFR(i) vfrag(vb_ + ((i) >> 2) * 16 * AV_STRIDE + ((i) & 3) * 64)
#define GAPA(i, HASP) do { if ((i) + 3 < 8) kr[((i) + 3) & 3] = KFR((i) + 3); \
        if ((i) < 4) { X1 = __builtin_amdgcn_mfma_f32_32x32x16_bf16(kr[(i) & 3], qf[(i) & 3], ((i) & 3) ? X1 : zero16, 0, 0, 0); \
            if (HASP) { sacc += (X0[(4 * (i)) & 15] + X0[(4 * (i) + 1) & 15]) + (X0[(4 * (i) + 2) & 15] + X0[(4 * (i) + 3) & 15]); \
                pw[((i) >> 1) & 1][((i) & 1) * 2] = cvtpk_s(X0[(4 * (i)) & 15], X0[(4 * (i) + 1) & 15]); pw[((i) >> 1) & 1][((i) & 1) * 2 + 1] = cvtpk_s(X0[(4 * (i) + 2) & 15], X0[(4 * (i) + 3) & 15]); asm volatile("" : "+v"(sacc)); } } \
        else X0 = __builtin_amdgcn_mfma_f32_32x32x16_bf16(kr[(i) & 3], qf[(i) & 3], ((i) & 3) ? X0 : zero16, 0, 0, 0); \
        SBAR(); } while (0)
#define EXC_(v) do { if (MODE & 1) break; if ((v) < 16) X0[(v) & 15] = __builtin_amdgcn_exp2f(X0[(v) & 15] - mrun); else X1[(v) & 15] = __builtin_amdgcn_exp2f(X1[(v) & 15] - mrun); } while (0)
#define GAPB(i, HASP) do { if ((HASP) && !(MODE & 4)) { if ((i) + 3 < 16) vr[((i) + 3) & 3] = VFR((i) + 3); \
            o[(i) & 3] = __builtin_amdgcn_mfma_f32_32x32x16_bf16(vr[(i) & 3], __builtin_bit_cast(bf16x8, pw[(i) >> 2]), o[(i) & 3], 0, 0, 0); } \
        EXC_(2 * (i)); EXC_(2 * (i) + 1); if ((i) < 8) asm volatile("" : "+v"(X0)); else asm volatile("" : "+v"(X1)); SBAR(); } while (0)
#define STEP(t, s0, HASP, DOK, DOV, WAITB) do { \
        const int s1_ = ((s0) == 2) ? 0 : (s0) + 1, s2_ = ((s0) == 0) ? 2 : (s0) - 1;     \
        const LAS unsigned char* kb_ = lds + (s0) * AKS + koff; const LAS unsigned char* vb_ = lds + s2_ * AVS + voff; \
        DMA_KV((t) + 2, s2_, (t) + 1, s1_, DOK, DOV); \
        bf16x8 kr[4]; kr[0] = KFR(0); kr[1] = KFR(1); kr[2] = KFR(2); float sacc = 0.f; SBAR(); \
        GAPA(0, HASP); GAPA(1, HASP); GAPA(2, HASP); GAPA(3, HASP); GAPA(4, HASP); GAPA(5, HASP); GAPA(6, HASP); GAPA(7, HASP); \
        lrun += sacc; \
        bf16x8 vr[4]; if ((HASP) && !(MODE & 4)) { vr[0] = VFR(0); vr[1] = VFR(1); vr[2] = VFR(2); } \
        float mx = fmaxf(X0[0], X1[0]); \
        if (!(MODE & 1)) { _Pragma("unroll") for (int r_ = 1; r_ < 16; ++r_) mx = max3f(mx, X0[r_], X1[r_]); } \
        { auto rr_ = __builtin_amdgcn_permlane32_swap(__float_as_uint(mx), __float_as_uint(mx), false, false); mx = max3f(mx, __uint_as_float(rr_[0]), __uint_as_float(rr_[1])); } \
        const bool resc = __any(mx > mrun); const float mn = max3f(mrun, mrun, mx), fsc = __builtin_amdgcn_exp2f(mrun - mn); lrun *= fsc; mrun = mn;     \
        SBAR(); \
        GAPB(0, HASP); GAPB(1, HASP); GAPB(2, HASP); GAPB(3, HASP); GAPB(4, HASP); GAPB(5, HASP); GAPB(6, HASP); GAPB(7, HASP); \
        GAPB(8, HASP); GAPB(9, HASP); GAPB(10, HASP); GAPB(11, HASP); GAPB(12, HASP); GAPB(13, HASP); GAPB(14, HASP); GAPB(15, HASP); \
        if (resc) { _Pragma("unroll") for (int db_ = 0; db_ < 4; ++db_) o[db_] = o[db_] * fsc; } \
        { float st_ = 0.f; _Pragma("unroll") for (int r_ = 0; r_ < 16; ++r_) st_ += X1[r_]; lrun += st_; \
          pw[2] = (u32x4){cvtpk_s(X1[0], X1[1]), cvtpk_s(X1[2], X1[3]), cvtpk_s(X1[4], X1[5]), cvtpk_s(X1[6], X1[7])}; \
          pw[3] = (u32x4){cvtpk_s(X1[8], X1[9]), cvtpk_s(X1[10], X1[11]), cvtpk_s(X1[12], X1[13]), cvtpk_s(X1[14], X1[15])}; } \
        WAITB(); } while (0)
    STEP(0, 0, false, true, true, WAIT_BAR5);
    { int s0 = 1;
      for (int t = 1; t < NT - 2; ++t) { STEP(t, s0, true, true, true, WAIT_BAR5); s0 = (s0 == 2) ? 0 : s0 + 1; } }
    STEP(NT - 2, (NT - 2) % 3, true, false, true, WAIT_BAR0);
    STEP(NT - 1, (NT - 1) % 3, true, false, false, WAIT_BAR0);
    { float sacc = 0.f;
#pragma unroll
      for (int r = 0; r < 16; ++r) sacc += X0[r];
      lrun += sacc;
      pw[0] = (u32x4){cvtpk_s(X0[0], X0[1]), cvtpk_s(X0[2], X0[3]), cvtpk_s(X0[4], X0[5]), cvtpk_s(X0[6], X0[7])};
      pw[1] = (u32x4){cvtpk_s(X0[8], X0[9]), cvtpk_s(X0[10], X0[11]), cvtpk_s(X0[12], X0[13]), cvtpk_s(X0[14], X0[15])};
      const LAS unsigned char* vb_ = lds + ((NT - 1) % 3) * AVS + voff;
#pragma unroll
      for (int i = 0; i < 16; ++i) o[i & 3] = __builtin_amdgcn_mfma_f32_32x32x16_bf16(VFR(i), __builtin_bit_cast(bf16x8, pw[i >> 2]), o[i & 3], 0, 0, 0);
    }
    __syncthreads();
#undef DMA_I
#undef DMA_KV
#undef KFR
#undef VFR
#undef GAPA
#undef EXC_
#undef GAPB
#undef STEP
    lrun += __shfl_xor(lrun, 32);
    const float rl = 1.0f / lrun;
    LAS float* ex = (LAS float*)lds + qw * 4096;
    if (map == 1) {
#pragma unroll
        for (int db = 0; db < 4; ++db)
#pragma unroll
            for (int r = 0; r < 16; ++r) ex[(db * 16 + r) * 64 + lane] = o[db][r] * rl;
    }
    __syncthreads();
    if (map == 0) {
        float ss = 0.f;
#pragma unroll
        for (int db = 0; db < 4; ++db)
#pragma unroll
            for (int r = 0; r < 16; ++r) { const float v = o[db][r] * rl - lam * ex[(db * 16 + r) * 64 + lane]; o[db][r] = v; ss += v * v; }
        ss += __shfl_xor(ss, 32);
        const float rstd = (1.0f - LAM_INIT) / sqrtf(ss * (1.0f / 128.0f) + EPS);
        bf16* op = MIX + qrow * D + h * 128;
#pragma unroll
        for (int db = 0; db < 4; ++db)
#pragma unroll
            for (int rq = 0; rq < 4; ++rq) { const int d0 = 32 * db + 8 * rq + 4 * hi; const f32x4 gsv = *(const LAS f32x4*)(lds + 131072 + 2048 + d0 * 4);
                u32x2 w; w.x = cvtpk(o[db][4 * rq] * rstd * gsv.x, o[db][4 * rq + 1] * rstd * gsv.y); w.y = cvtpk(o[db][4 * rq + 2] * rstd * gsv.z, o[db][4 * rq + 3] * rstd * gsv.w);
                *(u32x2*)(op + d0) = w; }
    }
    __syncthreads();
}
#undef SBAR

#define XB_TMO      128
#define XB_XCNT(j)  (256  + 64 * (j))
#define XB_XSUB(j)  (1280 + 64 * (j))
#define XB_XGEN(j)  (2304 + 64 * (j))
#define XB_TOP      3328
#define XB_TOPGEN   3392
#define XCD_BAR_WORDS 3456
#define XB_SPIN_CAP (1u << 18)

__device__ __forceinline__ unsigned xb_ld(unsigned* p)              { return __hip_atomic_load(p, __ATOMIC_RELAXED, __HIP_MEMORY_SCOPE_AGENT); }
__device__ __forceinline__ unsigned xb_add(unsigned* p, unsigned v) { return __hip_atomic_fetch_add(p, v, __ATOMIC_RELAXED, __HIP_MEMORY_SCOPE_AGENT); }
__device__ __forceinline__ unsigned xb_xcc_id() { return (unsigned)__builtin_amdgcn_s_getreg((3 << 11) | 20) & 0xFu; }
#define XB_SPIN(cond, bar) do { unsigned _sp = 0; while (cond) { __builtin_amdgcn_s_sleep(1); \
    if ((++_sp & 255u) == 0u) { if (xb_ld(&(bar)[XB_TMO])) break; if (_sp > XB_SPIN_CAP) { atomicAdd(&(bar)[XB_TMO], 1u); break; } } } } while (0)

struct XcdBarrier {
    unsigned* bar; unsigned x;
    volatile LAS unsigned* st;
};

__device__ __forceinline__ XcdBarrier xcd_barrier_post(unsigned* bar, volatile LAS unsigned* st) {
    XcdBarrier b; b.bar = bar; b.x = xb_xcc_id(); b.st = st;
    if (threadIdx.x == 0) (void)xb_add(&bar[XB_XCNT(b.x)], 1u);
    return b;
}
__device__ __forceinline__ void xcd_barrier_complete(unsigned* bar, unsigned x, unsigned& nloc, unsigned& nx) {
    const unsigned G = gridDim.x * gridDim.y * gridDim.z;
    unsigned sum, cnt, mine, sp = 0u;
    for (;;) {
        sum = 0u; cnt = 0u; mine = 0u;
#pragma unroll
        for (unsigned j = 0; j < 16; ++j) { const unsigned c = xb_ld(&bar[XB_XCNT(j)]); sum += c; cnt += (c > 0u) ? 1u : 0u; mine = (j == x) ? c : mine; }
        if (sum == G) break;
        __builtin_amdgcn_s_sleep(1);
        if ((++sp & 255u) == 0u) { if (xb_ld(&bar[XB_TMO])) break; if (sp > XB_SPIN_CAP) { atomicAdd(&bar[XB_TMO], 1u); break; } }
    }
    nloc = mine > 0u ? mine : 1u; nx = cnt > 0u ? cnt : 1u;
}

__device__ __forceinline__ void xcd_barrier(const XcdBarrier& b) {
    asm volatile("s_waitcnt vmcnt(0)" ::: "memory");
    __syncthreads();
    if (threadIdx.x == 0) {
        unsigned* bar = b.bar;
        __builtin_amdgcn_s_waitcnt(0);
        unsigned nloc = b.st[0], nx = b.st[1];
        if (nloc == 0u) { xcd_barrier_complete(bar, b.x, nloc, nx); b.st[0] = nloc; b.st[1] = nx; }
        const unsigned old = xb_add(&bar[XB_XSUB(b.x)], 1u);
        const unsigned gen = old / nloc;
        if (old + 1u == (gen + 1u) * nloc) {
            __builtin_amdgcn_fence(__ATOMIC_RELEASE, "agent");
            asm volatile("s_waitcnt vmcnt(0)" ::: "memory");
            const unsigned og = xb_add(&bar[XB_TOP], 1u);
            const unsigned tg = og / nx;
            if (og + 1u == (tg + 1u) * nx) xb_add(&bar[XB_TOPGEN], 1u);
            else XB_SPIN(xb_ld(&bar[XB_TOPGEN]) == tg, bar);
            __builtin_amdgcn_fence(__ATOMIC_ACQUIRE, "agent");
            xb_add(&bar[XB_XGEN(b.x)], 1u);
            asm volatile("s_waitcnt vmcnt(0)" ::: "memory");
        } else {
            XB_SPIN(xb_ld(&bar[XB_XGEN(b.x)]) == gen, bar);
            __builtin_amdgcn_fence(__ATOMIC_ACQUIRE, "agent");
            asm volatile("s_waitcnt vmcnt(0)" ::: "memory");
        }
    }
    __syncthreads();
}

struct Args { const float* in[23]; float* out; unsigned char* ws; int ph_lo, ph_hi; };
__global__ void __launch_bounds__(NWAVES * 64, 2) mk_fwd(Args a) {
    extern __shared__ __attribute__((aligned(16))) unsigned char lds_raw[];
    LAS unsigned char* lds = (LAS unsigned char*)lds_raw;
    const int tid = threadIdx.x, lane = tid & 63, wave = __builtin_amdgcn_readfirstlane(tid >> 6), G = gridDim.x, bx = blockIdx.x;
    unsigned char* ws = a.ws;
    const float *x = a.in[0], *c = a.in[1], *ctx = a.in[2], *c_ctx = a.in[3], *w_mod = a.in[4], *b_mod = a.in[5], *g_ffn1 = a.in[6], *ffn1_w_in = a.in[7], *ffn1_w_out = a.in[8],
                *g_mix = a.in[9], *w_in = a.in[10], *lq1 = a.in[11], *lk1 = a.in[12], *lq2 = a.in[13], *lk2 = a.in[14], *g_sub = a.in[15], *w_pool = a.in[16], *pool_scale = a.in[17],
                *w_out = a.in[18], *g_ffn2 = a.in[19], *ffn2_w_in = a.in[20], *ffn2_w_out = a.in[21], *g_final = a.in[22];
    float* mod = (float*)(ws + WS_MOD);
    bf16 *W1A = (bf16*)(ws + WS_W1A), *W2A = (bf16*)(ws + WS_W2A), *W1B = (bf16*)(ws + WS_W1B), *W2B = (bf16*)(ws + WS_W2B), *WINt = (bf16*)(ws + WS_WIN), *WOUTt = (bf16*)(ws + WS_WOUT), *WPt = (bf16*)(ws + WS_WP);
    bf16 *HN = (bf16*)(ws + WS_HN), *MIX = (bf16*)(ws + WS_HN), *ACT = (bf16*)(ws + WS_BIG), *HX = (bf16*)(ws + WS_BIG)  , *KP = (bf16*)(ws + WS_BIG + 68 * MiB), *VP = (bf16*)(ws + WS_BIG + 102 * MiB);
    float* X1 = (float*)(ws + WS_X1);
    float* xpart = (float*)(ws + 44 * MiB); unsigned* xcnt = (unsigned*)(ws + 700 * 1024);
    constexpr int I1 = (D / 64) * (2 * DFF / 32), I2 = (DFF / 64) * (D / 32), I3 = (D / 64) * (INW / 32), I4 = (D / 64) * (D / 32), I5 = 4 * 2 * 4;
#define CONV_RANGE(ilo, ihi, first_wg) do { const int fw_ = ((first_wg) < G) ? (first_wg) : 0; if (bx >= fw_) { LAS float* scr = (LAS float*)(lds + wave * 16384); \
        for (int it = (ilo) + (bx - fw_) * NWAVES + wave; it < (ihi); it += (G - fw_) * NWAVES) { int r = it; \
            if (r < I1) { transpose_mat_item(ffn1_w_in, D, 2 * DFF, W1A, true, r, scr, lane); continue; } r -= I1; \
            if (r < I1) { transpose_mat_item(ffn2_w_in, D, 2 * DFF, W1B, true, r, scr, lane); continue; } r -= I1; \
            if (r < I2) { transpose_mat_item(ffn1_w_out, DFF, D, W2A, false, r, scr, lane); continue; } r -= I2; \
            if (r < I2) { transpose_mat_item(ffn2_w_out, DFF, D, W2B, false, r, scr, lane); continue; } r -= I2; \
            if (r < I3) { transpose_mat_item(w_in, D, INW, WINt, false, r, scr, lane); continue; } r -= I3; \
            if (r < I4) { transpose_mat_item(w_out, D, D, WOUTt, false, r, scr, lane); continue; } r -= I4; \
            { const int gi = r >> 3; transpose_mat_item(w_pool + (size_t)gi * 128 * 128, 128, 128, WPt + (size_t)gi * 128 * 128, false, r & 7, scr, lane); } } } } while (0)
    const int lo = a.ph_lo, hi = a.ph_hi;
#define IN(k) (lo <= (k) && (k) < hi)
#define SEAM(k) do { if (IN(k) && IN((k) + 1)) xcd_barrier(bar); } while (0)

    if (tid < 4) ((volatile LAS unsigned*)(lds + 131072 + 64))[tid] = 0u;
    __syncthreads();
    if (IN(0)) {
        if (bx == 0) for (int i = tid; i < XCD_BAR_WORDS; i += 512) ((unsigned*)(ws + WS_BAR))[i] = 0u;
        for (int i = bx * 512 + tid; i < 3 * 128 * 64; i += G * 512) xcnt[i] = 0u;
        for (int u = bx; u < 144; u += G) adaln_unit(lds, u, c, c_ctx, w_mod, b_mod, mod, tid);
        CONV_RANGE(0, I1, 0); CONV_RANGE(2 * I1, 2 * I1 + I2, 0);
    }
    XcdBarrier bar; bar.bar = (unsigned*)(ws + WS_BAR); bar.x = 0; bar.st = nullptr;
    if (IN(0) && IN(1)) {
        cg::this_grid().sync();
        bar.bar = (unsigned*)(ws + WS_BAR); bar.x = xb_xcc_id(); bar.st = (volatile LAS unsigned*)(lds + 131072 + 64);
        if (tid == 0) bar.st[2] = xb_add(&bar.bar[XB_XCNT(bar.x)], 1u);
    }
    if (IN(1)) norm_pass(x, ctx, NTOK, g_ffn1, mod, 0, 1, HN, nullptr, wave, lane);
    SEAM(1);
    if (IN(2)) { pg8::Gemm g{HN, W1A, NTOK, 2 * DFF, D}; pg8::StaticOrder S; S.init(NTOK, 2 * DFF, G, bx, D); pg8::EpiSwiglu E{ACT, DFF};
        pg8::gemm_phase<pg8::EpiSwiglu, pg8::StaticOrder, true, true>(lds, g, S, E);
        CONV_RANGE(2 * I1 + 2 * I2, 2 * I1 + 2 * I2 + I3 + I4 + I5, ((NTOK / 256) * (2 * DFF / 256)) % G); }
    SEAM(2);
    if (IN(3)) { pg8::Gemm g{ACT, W2A, NTOK, D, DFF};
        { pg8::StaticOrder S; S.init(NLAT, D, G, bx, DFF);
          pg8::EpiResidRms<1, false> E{x, X1, mod + 2 * D, g_mix, mod + 4 * D, mod + 3 * D, HN, xpart, xcnt, (PG8_LAS float*)(lds + 131072 + 1024), nullptr};
          pg8::gemm_phase<pg8::EpiResidRms<1, false>, pg8::StaticOrder, true, true>(lds, g, S, E); }
        { pg8::SplitOnlyOrder S; S.init(NLAT, G, bx);
          pg8::EpiSplitRaw E{a.out};
          pg8::gemm_phase<pg8::EpiSplitRaw, pg8::SplitOnlyOrder, true, true>(lds, g, S, E); }
        CONV_RANGE(2 * I1 + I2, 2 * I1 + 2 * I2, 128); }
    SEAM(3);
    if (IN(4)) norm_pass(X1, ctx, NTOK, g_mix, mod, 3, 4, HN, nullptr, wave, lane, a.out, mod + (size_t)8 * NMOD + 2 * D, NLAT);
    SEAM(4);
    if (IN(5)) { pg8::Gemm g{HN, WINt, NTOK, INW, D}; pg8::StaticOrder S; S.init(NTOK, INW, G, bx, D); pg8::EpiInproj E{HX, KP, VP, QSCALE};
        pg8::gemm_phase<pg8::EpiInproj, pg8::StaticOrder, true, true>(lds, g, S, E);
        CONV_RANGE(I1, 2 * I1, ((NTOK / 256) * (INW / 256)) % G); }
    SEAM(5);
    if (IN(6)) {
        { u32x4 pv[5], pw_[4]; int u = bx;
          if (u < 1024) pool_load(u >> 2, (u + (u >> 8)) & 3, HX, WPt, pv, pw_, tid);
          for (; u < 1024; u += G) { pool_stage(lds, pv, pw_, tid); __syncthreads();
              const int un = u + G; if (un < 1024) pool_load(un >> 2, (un + (un >> 8)) & 3, HX, WPt, pv, pw_, tid);
              pool_compute(lds, u >> 2, (u + (u >> 8)) & 3, pool_scale, MIX, tid, wave, lane); } }
        __syncthreads();
        float d1 = 0.f, d2 = 0.f;
        for (int i = 0; i < 64; ++i) { d1 += lq1[i] * lk1[i]; d2 += lq2[i] * lk2[i]; }
        if (tid < 128) ((LAS float*)(lds + 131072 + 2048))[tid] = g_sub[tid];
        const float lam = __expf(d1) - __expf(d2) + LAM_INIT;
        int xcd = bx & 7, j = bx >> 3;
        if (IN(0)) {
            bool okc = (G == 256);
            for (int q = 0; q < 8; ++q) okc = okc && (xb_ld(&bar.bar[XB_XCNT(q)]) == 32u);
            if (okc && bar.x < 8u) { xcd = (int)bar.x; j = (int)((volatile LAS unsigned*)(lds + 131072 + 64))[2]; }
        }
        for (int u = j; u < 128; u += (G >> 3)) { const int bh = 4 * xcd + (u >> 5), qb = u & 31; attn_unit<0>(lds, bh >> 2, bh & 3, qb, HX, KP, VP, MIX, g_sub, lam, tid, wave, lane); }
    }
    SEAM(6);
    if (IN(7)) { pg8::Gemm g{MIX, WOUTt, NLAT, D, D}; pg8::StaticOrder S; S.init(NLAT, D, G, bx, D);
        pg8::EpiResidRms<2, false> E{X1, X1, mod + 5 * D, g_ffn2, mod + 7 * D, mod + 6 * D, (bf16*)a.out, xpart, xcnt + 1 * 128 * 64, (PG8_LAS float*)(lds + 131072 + 1024), nullptr};
        pg8::gemm_phase<pg8::EpiResidRms<2, false>, pg8::StaticOrder, true, true>(lds, g, S, E); }
    SEAM(7);
    if (IN(9)) { pg8::Gemm g{(const bf16*)a.out, W1B, NLAT, 2 * DFF, D}; pg8::StaticOrder S; S.init(NLAT, 2 * DFF, G, bx, D); pg8::EpiSwiglu E{ACT, DFF};
        pg8::gemm_phase<pg8::EpiSwiglu, pg8::StaticOrder, true, true>(lds, g, S, E); }
    SEAM(9);
    if (IN(10)) { pg8::Gemm g{ACT, W2B, NLAT, D, DFF}; pg8::StaticOrder S; S.init(NLAT, D, G, bx, DFF);
        pg8::EpiResidRms<1, true> E{X1, a.out, mod + 8 * D, g_final, nullptr, nullptr, nullptr, xpart, xcnt + 2 * 128 * 64, (PG8_LAS float*)(lds + 131072 + 1024), nullptr};
        pg8::gemm_phase<pg8::EpiResidRms<1, true>, pg8::StaticOrder, true, true>(lds, g, S, E); }
#undef IN
#undef CONV_RANGE
#undef SEAM
}

extern "C" void kernel_launch(void* const* d_in, const int* in_sizes, int n_in, void* d_out, int out_size, void* d_ws, size_t ws_size, hipStream_t stream) {
    static int grid = 0;
    if (grid == 0) {
        if (n_in != 23 || in_sizes[0] != NLAT * D || out_size != NLAT * D || ws_size < WS_END) { fprintf(stderr, "kernel_launch: unexpected shapes (n_in %d, in0 %d, out %d, ws %zu)\n", n_in, n_in > 0 ? in_sizes[0] : -1, out_size, ws_size); grid = -1; return; }
        int dev = 0, cus = 0, per_cu = 0;
        if (hipGetDevice(&dev) != hipSuccess || hipDeviceGetAttribute(&cus, hipDeviceAttributeMultiprocessorCount, dev) != hipSuccess) { grid = -1; return; }
        if (hipFuncSetAttribute((const void*)mk_fwd, hipFuncAttributeMaxDynamicSharedMemorySize, LDS_BYTES) != hipSuccess) { fprintf(stderr, "kernel_launch: hipFuncSetAttribute failed\n"); grid = -1; return; }
        if (hipOccupancyMaxActiveBlocksPerMultiprocessor(&per_cu, (const void*)mk_fwd, NWAVES * 64, LDS_BYTES) != hipSuccess || per_cu < 1) { fprintf(stderr, "kernel_launch: occupancy query says %d blocks/CU\n", per_cu); grid = -1; (void)hipGetLastError(); return; }
        grid = cus;
    }
    if (grid < 0) return;
    Args a{};
    for (int i = 0; i < 23; ++i) a.in[i] = (const float*)d_in[i];
    a.out = (float*)d_out; a.ws = (unsigned char*)d_ws;
#if MK_N_LAUNCHES == 1
    a.ph_lo = 0; a.ph_hi = NPHASE;
    void* args[] = {&a};
    hipError_t e = hipLaunchCooperativeKernel((const void*)mk_fwd, dim3(grid), dim3(NWAVES * 64), args, LDS_BYTES, stream);
    if (e != hipSuccess) fprintf(stderr, "kernel_launch: cooperative launch failed: %s (grid %d)\n", hipGetErrorString(e), grid);
#else
    for (int p = 0; p < NPHASE; ++p) { a.ph_lo = p; a.ph_hi = p + 1; hipLaunchKernelGGL(mk_fwd, dim3(grid), dim3(NWAVES * 64), LDS_BYTES, stream, a); }
#endif
}
```
